# Optimizing an MI355X kernel written in HIP

```python
import jax
import jax.numpy as jnp
from jax import lax
import numpy as np

D_MODEL = 1024
BATCH = 8
SEQ = 4096
DEPTH = 1

N_MEM = 256
ROPE_THETA = 500000.0
NORM_EPS = 1e-6
NEG_INF = -1e30
Q_BLOCK = 128
N_BRANCHES = 3

MLA_HEADS = 8
MLA_Q_RANK = 384
MLA_KV_RANK = 128
MLA_NOPE_DIM = 64
MLA_ROPE_DIM = 32
MLA_V_DIM = 64
MLA_QK_DIM = MLA_NOPE_DIM + MLA_ROPE_DIM

DIL_GROUPS = ((128, 1), (512, 4), (2048, 16))
DIL_HEADS = 4
DIL_HEAD_DIM = 64
DIL_ROPE_DIM = DIL_HEAD_DIM // 4
DIL_WIDTH = len(DIL_GROUPS) * DIL_HEADS * DIL_HEAD_DIM

MEM_HEADS = 4
MEM_HEAD_DIM = 128
MEM_WIDTH = MEM_HEADS * MEM_HEAD_DIM

D_FF = 2816

IN_SPLITS = (MLA_Q_RANK, MLA_KV_RANK, MLA_ROPE_DIM,
             DIL_WIDTH, DIL_WIDTH, DIL_WIDTH,
             MEM_WIDTH, N_BRANCHES * D_MODEL)
D_IN = sum(IN_SPLITS)

kernel_name = 'hybrid_mla_dilated_mem_encoder_block'


def rms_norm(x, g):
    xf = x.astype(jnp.float32)
    y = xf * lax.rsqrt(jnp.mean(xf * xf, axis=-1, keepdims=True) + NORM_EPS)
    return (y * g.astype(jnp.float32)).astype(x.dtype)


def swiglu(h, w_gate, w_up, w_down):
    return (jax.nn.silu(h @ w_gate) * (h @ w_up)) @ w_down


def split_columns(z, sizes):
    outs, start = [], 0
    for n in sizes:
        outs.append(z[..., start:start + n])
        start += n
    return outs


def rope(x, pos, rot_dim):
    half = rot_dim // 2
    inv_freq = ROPE_THETA ** (-2.0 * jnp.arange(half, dtype=jnp.float32) / rot_dim)
    ang = pos.astype(jnp.float32)[..., None] * inv_freq
    cos = jnp.cos(ang)[:, :, None, :]
    sin = jnp.sin(ang)[:, :, None, :]
    xr = x[..., :rot_dim].astype(jnp.float32)
    x1, x2 = xr[..., :half], xr[..., half:]
    rot = jnp.concatenate([x1 * cos - x2 * sin, x2 * cos + x1 * sin], axis=-1).astype(x.dtype)
    return jnp.concatenate([rot, x[..., rot_dim:]], axis=-1)


def dense_block_attention(q, k, v):
    B, S, H, dq = q.shape
    nq = S // Q_BLOCK
    scale = dq ** -0.5
    qb = q.reshape(B, nq, Q_BLOCK, H, dq).transpose(1, 0, 2, 3, 4)

    def attend(q_blk):
        s = jnp.einsum('bqhc,bkhc->bhqk', q_blk, k).astype(jnp.float32) * scale
        p = jax.nn.softmax(s, axis=-1).astype(v.dtype)
        return jnp.einsum('bhqk,bkhc->bqhc', p, v)

    o = lax.map(attend, qb)
    return o.transpose(1, 0, 2, 3, 4).reshape(B, S, H, v.shape[-1])


def dilated_window_attention(q, k, v, dilation, n_side):
    B, S, H, dh = q.shape
    L = S // dilation
    blk = n_side
    nb = -(-L // blk)
    Lp = nb * blk

    def classes(t):
        t = t.reshape(B, L, dilation, H, dh).transpose(0, 2, 1, 3, 4)
        return jnp.pad(t, ((0, 0), (0, 0), (0, Lp - L), (0, 0), (0, 0)))

    def windows(t):
        tp = jnp.pad(t, ((0, 0), (0, 0), (blk, blk), (0, 0), (0, 0)))
        tp = tp.reshape(B, dilation, nb + 2, blk, H, dh)
        return jnp.concatenate([tp[:, :, :-2], tp[:, :, 1:-1], tp[:, :, 2:]], axis=3)

    qb = classes(q).reshape(B, dilation, nb, blk, H, dh)
    kw = windows(classes(k))
    vw = windows(classes(v))

    q_idx = jnp.arange(Lp).reshape(nb, blk)
    k_idx = jnp.arange(nb)[:, None] * blk - blk + jnp.arange(3 * blk)[None, :]
    rel = k_idx[:, None, :] - q_idx[:, :, None]
    mask = (jnp.abs(rel) <= n_side) & (k_idx[:, None, :] >= 0) & (k_idx[:, None, :] < L)

    s = jnp.einsum('bdnqhc,bdnkhc->bdnhqk', qb, kw).astype(jnp.float32) * dh ** -0.5
    s = jnp.where(mask[:, None], s, NEG_INF)
    lse = jax.nn.logsumexp(s, axis=-1)
    p = jnp.exp(s - lse[..., None]).astype(v.dtype)
    o = jnp.einsum('bdnhqk,bdnkhc->bdnqhc', p, vw)
    o = o.reshape(B, dilation, Lp, H, dh)[:, :, :L].transpose(0, 2, 1, 3, 4).reshape(B, S, H, dh)
    lse = lse.transpose(0, 1, 2, 4, 3).reshape(B, dilation, Lp, H)[:, :, :L]
    lse = lse.transpose(0, 2, 1, 3).reshape(B, S, H)
    return o, lse


def mla_branch(c_q, c_kv, k_r, pos, q_norm, w_uq, kv_norm, w_ukv, w_o):
    B, S, _ = c_q.shape
    q = (rms_norm(c_q, q_norm) @ w_uq).reshape(B, S, MLA_HEADS, MLA_QK_DIM)
    q = jnp.concatenate([q[..., :MLA_NOPE_DIM],
                         rope(q[..., MLA_NOPE_DIM:], pos, MLA_ROPE_DIM)], axis=-1)
    kv = (rms_norm(c_kv, kv_norm) @ w_ukv).reshape(B, S, MLA_HEADS, MLA_NOPE_DIM + MLA_V_DIM)
    k_rope = rope(k_r[:, :, None, :], pos, MLA_ROPE_DIM)
    k = jnp.concatenate([kv[..., :MLA_NOPE_DIM],
                         jnp.broadcast_to(k_rope, (B, S, MLA_HEADS, MLA_ROPE_DIM))], axis=-1)
    v = kv[..., MLA_NOPE_DIM:]
    o = dense_block_attention(q, k, v)
    return o.reshape(B, S, MLA_HEADS * MLA_V_DIM) @ w_o


def dilated_branch(q, k, v, pos, w_o):
    B, S, _ = q.shape
    G = len(DIL_GROUPS)

    def heads(t):
        t = t.reshape(B, S, G * DIL_HEADS, DIL_HEAD_DIM)
        return t

    qh = rope(heads(q), pos, DIL_ROPE_DIM).reshape(B, S, G, DIL_HEADS, DIL_HEAD_DIM)
    kh = rope(heads(k), pos, DIL_ROPE_DIM).reshape(B, S, G, DIL_HEADS, DIL_HEAD_DIM)
    vh = v.reshape(B, S, G, DIL_HEADS, DIL_HEAD_DIM)
    outs, lses = [], []
    for g, (window, dilation) in enumerate(DIL_GROUPS):
        n_side = window // (2 * dilation)
        o, lse = dilated_window_attention(qh[:, :, g], kh[:, :, g], vh[:, :, g], dilation, n_side)
        outs.append(o)
        lses.append(lse)
    alpha = jax.nn.softmax(jnp.stack(lses, axis=0), axis=0)
    o = jnp.sum(alpha[..., None] * jnp.stack(outs, axis=0).astype(jnp.float32), axis=0)
    return o.astype(q.dtype).reshape(B, S, DIL_HEADS * DIL_HEAD_DIM) @ w_o


def memory_branch(q, mem, mem_norm, w_kv, w_o):
    B, S, _ = q.shape
    M = mem.shape[1]
    kv = rms_norm(mem, mem_norm) @ w_kv
    km = kv[..., :MEM_WIDTH].reshape(B, M, MEM_HEADS, MEM_HEAD_DIM)
    vm = kv[..., MEM_WIDTH:].reshape(B, M, MEM_HEADS, MEM_HEAD_DIM)
    qh = q.reshape(B, S, MEM_HEADS, MEM_HEAD_DIM)
    s = jnp.einsum('bshc,bmhc->bhsm', qh, km).astype(jnp.float32) * MEM_HEAD_DIM ** -0.5
    p = jax.nn.softmax(s, axis=-1).astype(vm.dtype)
    o = jnp.einsum('bhsm,bmhc->bshc', p, vm)
    return o.reshape(B, S, MEM_WIDTH) @ w_o


def setup_inputs(seed: int = 0) -> dict:
    key = jax.random.key(seed)
    ks = jax.random.split(key, 24)
    f32 = jnp.float32

    def dense(k, shape):
        return jax.random.normal(k, shape, f32) * shape[-2] ** -0.5

    def gain(k, n):
        return 1.0 + 0.02 * jax.random.normal(k, (DEPTH, n), f32)

    offsets = jax.random.randint(ks[2], (BATCH, 1), 0, 1024, dtype=jnp.int32)
    positions = jnp.arange(SEQ, dtype=jnp.int32)[None, :] + offsets
    return {
        'x': jax.random.normal(ks[0], (BATCH, SEQ, D_MODEL), f32),
        'mem': jax.random.normal(ks[1], (BATCH, N_MEM, D_MODEL), f32),
        'positions': positions,
        'ffn1_norm': gain(ks[3], D_MODEL),
        'ffn1_w_gate': dense(ks[4], (DEPTH, D_MODEL, D_FF)),
        'ffn1_w_up': dense(ks[5], (DEPTH, D_MODEL, D_FF)),
        'ffn1_w_down': dense(ks[6], (DEPTH, D_FF, D_MODEL)),
        'mix_norm': gain(ks[7], D_MODEL),
        'w_in': dense(ks[8], (DEPTH, D_MODEL, D_IN)),
        'mla_q_norm': gain(ks[9], MLA_Q_RANK),
        'mla_w_uq': dense(ks[10], (DEPTH, MLA_Q_RANK, MLA_HEADS * MLA_QK_DIM)),
        'mla_kv_norm': gain(ks[11], MLA_KV_RANK),
        'mla_w_ukv': dense(ks[12], (DEPTH, MLA_KV_RANK, MLA_HEADS * (MLA_NOPE_DIM + MLA_V_DIM))),
        'mla_w_o': dense(ks[13], (DEPTH, MLA_HEADS * MLA_V_DIM, D_MODEL)),
        'dil_w_o': dense(ks[14], (DEPTH, DIL_HEADS * DIL_HEAD_DIM, D_MODEL)),
        'mem_norm': gain(ks[15], D_MODEL),
        'mem_w_kv': dense(ks[16], (DEPTH, D_MODEL, 2 * MEM_WIDTH)),
        'mem_w_o': dense(ks[17], (DEPTH, MEM_WIDTH, D_MODEL)),
        'w_out': dense(ks[18], (DEPTH, D_MODEL, D_MODEL)),
        'ffn2_norm': gain(ks[19], D_MODEL),
        'ffn2_w_gate': dense(ks[20], (DEPTH, D_MODEL, D_FF)),
        'ffn2_w_up': dense(ks[21], (DEPTH, D_MODEL, D_FF)),
        'ffn2_w_down': dense(ks[22], (DEPTH, D_FF, D_MODEL)),
        'final_norm': 1.0 + 0.02 * jax.random.normal(ks[23], (D_MODEL,), f32),
    }


def reference(x, mem, positions, ffn1_norm, ffn1_w_gate, ffn1_w_up, ffn1_w_down,
              mix_norm, w_in, mla_q_norm, mla_w_uq, mla_kv_norm, mla_w_ukv, mla_w_o,
              dil_w_o, mem_norm, mem_w_kv, mem_w_o, w_out,
              ffn2_norm, ffn2_w_gate, ffn2_w_up, ffn2_w_down, final_norm):
    B, S, _ = x.shape
    for l in range(DEPTH):
        x = x + 0.5 * swiglu(rms_norm(x, ffn1_norm[l]), ffn1_w_gate[l], ffn1_w_up[l], ffn1_w_down[l])

        h = rms_norm(x, mix_norm[l])
        z = h @ w_in[l]
        c_q, c_kv, k_r, dq, dk, dv, mq, gate_logits = split_columns(z, IN_SPLITS)

        y_mla = mla_branch(c_q, c_kv, k_r, positions, mla_q_norm[l], mla_w_uq[l],
                           mla_kv_norm[l], mla_w_ukv[l], mla_w_o[l])
        y_dil = dilated_branch(dq, dk, dv, positions, dil_w_o[l])
        y_mem = memory_branch(mq, mem, mem_norm[l], mem_w_kv[l], mem_w_o[l])

        gates = jax.nn.sigmoid(gate_logits.reshape(B, S, N_BRANCHES, D_MODEL))
        mixed = gates[:, :, 0] * y_mla + gates[:, :, 1] * y_dil + gates[:, :, 2] * y_mem
        x = x + mixed @ w_out[l]

        x = x + 0.5 * swiglu(rms_norm(x, ffn2_norm[l]), ffn2_w_gate[l], ffn2_w_up[l], ffn2_w_down[l])
    return rms_norm(x, final_norm)
```

```cpp
#include <hip/hip_runtime.h>
#include <hip/hip_cooperative_groups.h>
#include <cstdio>
#include <cstdint>
namespace cg = cooperative_groups;

#ifndef MK_PER_PHASE
#define MK_PER_PHASE 0
#endif

namespace pg8 {
#define PG8_LAS __attribute__((address_space(3)))
typedef unsigned short bf16_t;
typedef short bf16x8 __attribute__((ext_vector_type(8)));
typedef float f32x4 __attribute__((ext_vector_type(4)));
typedef unsigned u32x4 __attribute__((ext_vector_type(4)));
typedef unsigned u32x2 __attribute__((ext_vector_type(2)));
constexpr int BM = 256, BK = 64, HALF = 128, HTB = HALF * BK * 2  , STAGE_BYTES = 8 * HTB, NXCD = 8, WGM = 4;

__host__ __device__ __forceinline__ int lds_byte(int r, int c) { const int st = (r >> 4) * 2 + (c >> 5), rr = r & 15, cc = c & 31, ob = rr * 64 + cc * 2; return st * 1024 + (ob ^ (((ob >> 9) & 1) << 5)); }
__host__ __device__ __forceinline__ void stage_rc(int b, int& R, int& C) { const int st = b / 1024, sb = b % 1024, swz = sb ^ (((sb >> 9) & 1) << 5); R = (st >> 1) * 16 + swz / 64; C = (st & 1) * 32 + (swz % 64) / 2; }
__host__ __device__ __forceinline__ int perm32(int rho) { const int n = rho >> 4, i = rho & 15; return 8 * (i >> 2) + 4 * n + (i & 3); }

struct Unit { int pm, pn; };
struct Gemm { const bf16_t* A; const bf16_t* Bt; int M, N, K, lda, ldb; };

struct StaticOrder {
    int nM, nN, nwg, G, c;
    __host__ __device__ void init(int M, int N, int G_, int c_) { nM = M / BM; nN = N / BM; nwg = nM * nN; G = G_; c = c_; }
    __host__ __device__ bool next(int i, Unit& u) const {
        const long L = (long)i * G + c; if (L >= nwg) return false;
        int wgid = (int)L; { const int q = nwg / NXCD, r = nwg % NXCD, xcd = wgid % NXCD, off = wgid / NXCD; wgid = (xcd < r ? xcd * (q + 1) : r * (q + 1) + (xcd - r) * q) + off; }
        const int nig = WGM * nN, gid = wgid / nig, fm = gid * WGM, gsz = (nM - fm) < WGM ? (nM - fm) : WGM;
        u.pm = fm + ((wgid % nig) % gsz); u.pn = (wgid % nig) / gsz; return true;
    }
    __device__ __forceinline__ void a_ready(const Unit&) const {}
    __device__ __forceinline__ void done(const Unit&) const {}
};
struct GateOrder {
    StaticOrder so;
    __host__ __device__ void init(int M, int G_, int c_) { so.init(M, 1024, G_, c_); }
    __host__ __device__ bool next(int i, Unit& u) const {
        const int rnd = i / 3, b = 2 - i % 3; Unit t;
        if (!so.next(rnd, t)) return false;
        u.pm = t.pm; u.pn = b * 4 + t.pn; return true;
    }
    __device__ __forceinline__ void a_ready(const Unit&) const {}
    __device__ __forceinline__ void done(const Unit&) const {}
};

__device__ __forceinline__ int fresh_lane() { unsigned m = ~0u; asm volatile("" : "+s"(m)); return (int)__builtin_amdgcn_mbcnt_hi(m, __builtin_amdgcn_mbcnt_lo(m, 0u)); }
__device__ __forceinline__ unsigned cvt_pk_bf16(float lo, float hi) { unsigned r; asm volatile("v_cvt_pk_bf16_f32 %0, %1, %2" : "=v"(r) : "v"(lo), "v"(hi)); return r; }
__device__ __forceinline__ float bf_lo(unsigned w) { return __builtin_bit_cast(float, w << 16); }
__device__ __forceinline__ float bf_hi(unsigned w) { return __builtin_bit_cast(float, w & 0xffff0000u); }
__device__ __forceinline__ float sigmoidf_(float v) { return __builtin_amdgcn_rcpf(1.0f + __builtin_amdgcn_exp2f(-1.4426950408889634f * v)); }


struct EpiBf16 {
    static constexpr bool PERM = true, AFTER_DRAIN = false;
    bf16_t* O; int ldc; int ncols; float scale; bool keep;
    __device__ __forceinline__ void operator()(const f32x4 (&acc)[2][2][4][2], const Unit& u, int wr, int wc, int fr_, int fq_) const {
        int fr = fr_, fq = fq_; asm volatile("" : "+v"(fr), "+v"(fq));
        const int row0 = u.pm * BM + wr * 64 + fr; const int col0 = u.pn * BM + wc * 32 + 8 * fq;
#pragma unroll
        for (int ai = 0; ai < 2; ++ai)
#pragma unroll
            for (int m = 0; m < 4; ++m) { bf16_t* rowp = O + (size_t)(row0 + ai * HALF + m * 16) * ldc + col0;
#pragma unroll
                for (int bj = 0; bj < 2; ++bj) { const f32x4 v0 = acc[ai][bj][m][0] * scale, v1 = acc[ai][bj][m][1] * scale;
                    u32x4 w; w.x = cvt_pk_bf16(v0[0], v0[1]); w.y = cvt_pk_bf16(v0[2], v0[3]); w.z = cvt_pk_bf16(v1[0], v1[1]); w.w = cvt_pk_bf16(v1[2], v1[3]);
                    if (col0 + bj * HALF < ncols) { if (keep) *(u32x4*)(rowp + bj * HALF) = w; else __builtin_nontemporal_store(w, (u32x4*)(rowp + bj * HALF)); } } }
    }
};
struct EpiSwiglu {
    static constexpr bool PERM = true, AFTER_DRAIN = false;
    bf16_t* O; int ldc;
    __device__ __forceinline__ void operator()(const f32x4 (&acc)[2][2][4][2], const Unit& u, int wr, int wc, int fr_, int fq_) const {
        int fr = fr_, fq = fq_; asm volatile("" : "+v"(fr), "+v"(fq));
        const int row0 = u.pm * BM + wr * 64 + fr; const int col0 = u.pn * HALF + wc * 32 + 8 * fq;
#pragma unroll
        for (int ai = 0; ai < 2; ++ai)
#pragma unroll
            for (int m = 0; m < 4; ++m) { bf16_t* rowp = O + (size_t)(row0 + ai * HALF + m * 16) * ldc + col0;
                float v[8];
#pragma unroll
                for (int n = 0; n < 2; ++n)
#pragma unroll
                    for (int j = 0; j < 4; ++j) { const float g = acc[ai][0][m][n][j], up = acc[ai][1][m][n][j]; v[4 * n + j] = g * sigmoidf_(g) * up; }
                u32x4 w; w.x = cvt_pk_bf16(v[0], v[1]); w.y = cvt_pk_bf16(v[2], v[3]); w.z = cvt_pk_bf16(v[4], v[5]); w.w = cvt_pk_bf16(v[6], v[7]);
                __builtin_nontemporal_store(w, (u32x4*)rowp); }
    }
};
struct EpiResid {
    static constexpr bool PERM = false, AFTER_DRAIN = false;
    const float* base; float* out; int ldc; float scale;
    __device__ __forceinline__ void operator()(const f32x4 (&acc)[2][2][4][2], const Unit& u, int wr, int wc, int fr_, int fq_) const {
        int fr = fr_, fq = fq_; asm volatile("" : "+v"(fr), "+v"(fq));
        const int row0 = u.pm * BM + wr * 64 + fr; const int col0 = u.pn * BM + wc * 32 + 4 * fq;
#pragma unroll
        for (int ai = 0; ai < 2; ++ai)
#pragma unroll
            for (int m = 0; m < 4; ++m) { const size_t off = (size_t)(row0 + ai * HALF + m * 16) * ldc + col0;
#pragma unroll
                for (int bj = 0; bj < 2; ++bj)
#pragma unroll
                    for (int n = 0; n < 2; ++n) { const f32x4 b = *(const f32x4*)(base + off + bj * HALF + n * 16); *(f32x4*)(out + off + bj * HALF + n * 16) = b + acc[ai][bj][m][n] * scale; } }
    }
};
struct EpiQRope {
    static constexpr bool PERM = false, AFTER_DRAIN = false;
    bf16_t* O; int ldc; const float* tab; float qscale;
    __device__ __forceinline__ void operator()(const f32x4 (&acc)[2][2][4][2], const Unit& u, int wr, int wc, int fr_, int fq_) const {
        int fr = fr_, fq = fq_; asm volatile("" : "+v"(fr), "+v"(fq));
        const int row0 = u.pm * BM + wr * 64 + fr;
#pragma unroll
        for (int bj = 0; bj < 2; ++bj) { const int grp = u.pn * 8 + bj * 4 + wc; const bool rot = (grp % 3) == 2; const int col = grp * 32 + 4 * fq;
#pragma unroll
            for (int ai = 0; ai < 2; ++ai)
#pragma unroll
                for (int m = 0; m < 4; ++m) { const int row = row0 + ai * HALF + m * 16; f32x4 v0 = acc[ai][bj][m][0], v1 = acc[ai][bj][m][1];
                    if (rot) { const f32x4 t0 = *(const f32x4*)(tab + (size_t)row * 32 + 8 * fq), t1 = *(const f32x4*)(tab + (size_t)row * 32 + 8 * fq + 4);
                        const float c[4] = {t0[0], t0[2], t1[0], t1[2]}, s[4] = {t0[1], t0[3], t1[1], t1[3]};
#pragma unroll
                        for (int j = 0; j < 4; ++j) { const float x1 = v0[j], x2 = v1[j]; v0[j] = x1 * c[j] - x2 * s[j]; v1[j] = x2 * c[j] + x1 * s[j]; } }
                    v0 = v0 * qscale; v1 = v1 * qscale;
                    u32x2 w0, w1; w0.x = cvt_pk_bf16(v0[0], v0[1]); w0.y = cvt_pk_bf16(v0[2], v0[3]); w1.x = cvt_pk_bf16(v1[0], v1[1]); w1.y = cvt_pk_bf16(v1[2], v1[3]);
                    bf16_t* p = O + (size_t)row * ldc + col; *(u32x2*)p = w0; *(u32x2*)(p + 16) = w1; } }
    }
};
struct EpiGateMul {
    static constexpr bool PERM = true, AFTER_DRAIN = false;
    bf16_t* Y0; size_t ystride;
    __device__ __forceinline__ void operator()(const f32x4 (&acc)[2][2][4][2], const Unit& u, int wr, int wc, int fr_, int fq_) const {
        int fr = fr_, fq = fq_; asm volatile("" : "+v"(fr), "+v"(fq));
        const int b = u.pn >> 2, jn = u.pn & 3; const int row0 = u.pm * BM + wr * 64 + fr; const int col0 = jn * BM + wc * 32 + 8 * fq;
        const bf16_t* Yb = Y0 + (size_t)b * ystride; bf16_t* Ya = Y0 + (size_t)2 * ystride; const bool rmw = (b != 2);
#pragma unroll
        for (int ai = 0; ai < 2; ++ai) {
            u32x4 yv[4][2], pv[4][2];
#pragma unroll
            for (int m = 0; m < 4; ++m)
#pragma unroll
                for (int bj = 0; bj < 2; ++bj) { const size_t off = (size_t)(row0 + ai * HALF + m * 16) * 1024 + col0 + bj * HALF; yv[m][bj] = *(const u32x4*)(Yb + off); if (rmw) pv[m][bj] = *(const u32x4*)(Ya + off); }
#pragma unroll
            for (int m = 0; m < 4; ++m)
#pragma unroll
                for (int bj = 0; bj < 2; ++bj) { const size_t off = (size_t)(row0 + ai * HALF + m * 16) * 1024 + col0 + bj * HALF; const u32x4 y = yv[m][bj]; const f32x4 a0 = acc[ai][bj][m][0], a1 = acc[ai][bj][m][1];
                    float v[8];
                    v[0] = sigmoidf_(a0[0]) * bf_lo(y.x); v[1] = sigmoidf_(a0[1]) * bf_hi(y.x); v[2] = sigmoidf_(a0[2]) * bf_lo(y.y); v[3] = sigmoidf_(a0[3]) * bf_hi(y.y);
                    v[4] = sigmoidf_(a1[0]) * bf_lo(y.z); v[5] = sigmoidf_(a1[1]) * bf_hi(y.z); v[6] = sigmoidf_(a1[2]) * bf_lo(y.w); v[7] = sigmoidf_(a1[3]) * bf_hi(y.w);
                    if (rmw) { const u32x4 p = pv[m][bj];
                        v[0] += bf_lo(p.x); v[1] += bf_hi(p.x); v[2] += bf_lo(p.y); v[3] += bf_hi(p.y); v[4] += bf_lo(p.z); v[5] += bf_hi(p.z); v[6] += bf_lo(p.w); v[7] += bf_hi(p.w); }
                    u32x4 w; w.x = cvt_pk_bf16(v[0], v[1]); w.y = cvt_pk_bf16(v[2], v[3]); w.z = cvt_pk_bf16(v[4], v[5]); w.w = cvt_pk_bf16(v[6], v[7]);
                    *(u32x4*)(Ya + off) = w; }
        }
    }
};

template <class Epi, class Sched, bool ALIGN_EPI = false, bool SP2 = false>
__device__ __forceinline__ void gemm_phase(PG8_LAS unsigned char* lds, const Gemm g, const Sched& S, const Epi& E, const int wid_in) {
    const int lane = fresh_lane(), wid = wid_in, tid = wid * 64 + lane, wr = wid >> 2, wc = wid & 3, fr = lane & 15, fq = lane >> 4;
    const int K = g.K, nt = K / BK;
    unsigned voffA[2], voffB[2];
#pragma unroll
    for (int i = 0; i < 2; ++i) { int R, C; stage_rc(tid * 16 + i * 8192, R, C); const int Rb = Epi::PERM ? ((R & ~31) + perm32(R & 31)) : R;
        voffA[i] = (unsigned)(R * g.lda + C) * 2u; voffB[i] = (unsigned)(Rb * g.ldb + C) * 2u; }
    const size_t kstep = (size_t)(BK * 2);
    const size_t hstepA = (size_t)HALF * g.lda * 2, hstepB = (size_t)HALF * g.ldb * 2;
    const size_t tstepA = 2 * hstepA, tstepB = 2 * hstepB;
    const unsigned ldsw = (unsigned)wid * 1024u;
    const int aoff = lds_byte(wr * 64 + fr, fq * 8), boff = lds_byte(wc * 32 + fr, fq * 8);
#define PG8_SA(b, h) (((b) * 2 + (h)) * HTB)
#define PG8_SB(b, h) ((4 + (b) * 2 + (h)) * HTB)
#define PG8_STAGE(bufoff, gbase, voff) do { _Pragma("unroll") for (int _i = 0; _i < 2; ++_i) \
        __builtin_amdgcn_global_load_lds((const unsigned*)((const char*)(gbase) + (voff)[_i]), (PG8_LAS unsigned*)(lds + (bufoff) + ldsw + _i * 8192), 16, 0, 0); } while (0)
#define PG8_LDA(dst, b, h) do { _Pragma("unroll") for (int m = 0; m < 4; ++m) _Pragma("unroll") for (int k = 0; k < 2; ++k) dst[m][k] = *(const PG8_LAS bf16x8*)(lds + PG8_SA(b, h) + aoff + m * 2048 + k * 1024); } while (0)
#define PG8_LDB(dst, b, h) do { _Pragma("unroll") for (int n = 0; n < 2; ++n) _Pragma("unroll") for (int k = 0; k < 2; ++k) dst[n][k] = *(const PG8_LAS bf16x8*)(lds + PG8_SB(b, h) + boff + n * 2048 + k * 1024); } while (0)
#define PG8_MMA(ai, bj, At, Bt) do { __builtin_amdgcn_s_setprio(1); _Pragma("unroll") for (int m = 0; m < 4; ++m) _Pragma("unroll") for (int n = 0; n < 2; ++n) _Pragma("unroll") for (int k = 0; k < 2; ++k) \
        acc[ai][bj][m][n] = __builtin_amdgcn_mfma_f32_16x16x32_bf16(Bt[n][k], At[m][k], acc[ai][bj][m][n], 0, 0, 0); __builtin_amdgcn_s_setprio(0); } while (0)
#define PG8_WAIT_V(n) asm volatile("s_waitcnt vmcnt(" #n ")" ::: "memory")
#define PG8_WAIT_L(n) asm volatile("s_waitcnt lgkmcnt(" #n ")" ::: "memory")
#define PG8_BAR __builtin_amdgcn_s_barrier()
#define PG8_SCHED __builtin_amdgcn_sched_barrier(0)
    Unit cur, nxt; int ui = 0;
    if (!S.next(0, cur)) return;
    f32x4 acc[2][2][4][2];
#pragma unroll
    for (int a = 0; a < 2; ++a)
#pragma unroll
        for (int b = 0; b < 2; ++b)
#pragma unroll
            for (int m = 0; m < 4; ++m)
#pragma unroll
                for (int n = 0; n < 2; ++n) acc[a][b][m][n] = (f32x4){0.f, 0.f, 0.f, 0.f};
    bf16x8 At[4][2], B0[2][2], B1[2][2];
    const char* cA = (const char*)g.A + (size_t)cur.pm * tstepA; const char* cB = (const char*)g.Bt + (size_t)cur.pn * tstepB;
    S.a_ready(cur);
    if constexpr (SP2) {
        PG8_STAGE(PG8_SB(0, 0), cB, voffB); PG8_STAGE(PG8_SB(0, 1), cB + hstepB, voffB); PG8_STAGE(PG8_SA(0, 0), cA, voffA); PG8_STAGE(PG8_SA(0, 1), cA + hstepA, voffA);
        if (wr == 1) PG8_BAR;
        PG8_WAIT_V(2); PG8_BAR;
        PG8_STAGE(PG8_SB(1, 0), cB + kstep, voffB); PG8_STAGE(PG8_SA(1, 0), cA + kstep, voffA); PG8_STAGE(PG8_SB(1, 1), cB + hstepB + kstep, voffB);
        PG8_WAIT_V(6); PG8_BAR;
    } else {
        PG8_STAGE(PG8_SB(0, 0), cB, voffB); PG8_STAGE(PG8_SA(0, 0), cA, voffA); PG8_STAGE(PG8_SB(0, 1), cB + hstepB, voffB); PG8_STAGE(PG8_SA(0, 1), cA + hstepA, voffA);
        if (wr == 1) PG8_BAR;
        PG8_WAIT_V(4); PG8_BAR;
        PG8_STAGE(PG8_SB(1, 0), cB + kstep, voffB); PG8_STAGE(PG8_SA(1, 0), cA + kstep, voffA); PG8_STAGE(PG8_SB(1, 1), cB + hstepB + kstep, voffB);
        PG8_WAIT_V(6); PG8_BAR;
    }
    for (;;) {
        const bool has_next = S.next(ui + 1, nxt);
        const char* nA = has_next ? (const char*)g.A + (size_t)nxt.pm * tstepA : cA; const char* nB = has_next ? (const char*)g.Bt + (size_t)nxt.pn * tstepB : cB;
#pragma nounroll
        for (int t = 0; t < nt; t += 2) {
            const bool last = (t == nt - 2);
            const char* a1 = cA + (size_t)(t + 1) * kstep;
            const char* a2 = last ? nA : cA + (size_t)(t + 2) * kstep; const char* b2 = last ? nB : cB + (size_t)(t + 2) * kstep;
            const char* a3 = a2 + kstep; const char* b3 = b2 + kstep;
            if (last && has_next) S.a_ready(nxt);
            if constexpr (SP2) {
            PG8_LDB(B0, 0, 0); PG8_LDB(B1, 0, 1); PG8_SCHED; PG8_LDA(At, 0, 0); PG8_STAGE(PG8_SA(1, 1), a1 + hstepA, voffA);
            PG8_WAIT_V(8); PG8_WAIT_L(0); PG8_BAR; PG8_MMA(0, 0, At, B0); PG8_MMA(0, 1, At, B1); PG8_BAR; PG8_SCHED;
            PG8_LDA(At, 0, 1); PG8_STAGE(PG8_SB(0, 0), b2, voffB); PG8_STAGE(PG8_SB(0, 1), b2 + hstepB, voffB); PG8_STAGE(PG8_SA(0, 0), a2, voffA);
            PG8_WAIT_V(8); PG8_WAIT_L(0); PG8_BAR; PG8_MMA(1, 0, At, B0); PG8_MMA(1, 1, At, B1); PG8_BAR; PG8_SCHED;
            PG8_LDB(B0, 1, 0); PG8_LDB(B1, 1, 1); PG8_SCHED; PG8_LDA(At, 1, 0); PG8_STAGE(PG8_SA(0, 1), a2 + hstepA, voffA);
            PG8_WAIT_V(8); PG8_WAIT_L(0); PG8_BAR; PG8_MMA(0, 0, At, B0); PG8_MMA(0, 1, At, B1); PG8_BAR; PG8_SCHED;
            PG8_LDA(At, 1, 1); PG8_STAGE(PG8_SB(1, 0), b3, voffB); PG8_STAGE(PG8_SB(1, 1), b3 + hstepB, voffB); PG8_STAGE(PG8_SA(1, 0), a3, voffA);
            PG8_WAIT_V(8); PG8_WAIT_L(0); PG8_BAR; PG8_MMA(1, 0, At, B0); PG8_MMA(1, 1, At, B1); PG8_BAR; PG8_SCHED;
            } else {
            PG8_LDB(B0, 0, 0); PG8_SCHED; PG8_LDA(At, 0, 0); PG8_STAGE(PG8_SA(1, 1), a1 + hstepA, voffA);
            PG8_WAIT_L(8); PG8_BAR; PG8_WAIT_L(0); PG8_MMA(0, 0, At, B0); PG8_BAR; PG8_SCHED;
            PG8_LDB(B1, 0, 1); PG8_STAGE(PG8_SB(0, 0), b2, voffB);
            PG8_BAR; PG8_WAIT_L(0); PG8_MMA(0, 1, At, B1); PG8_BAR;
            PG8_LDA(At, 0, 1); PG8_STAGE(PG8_SA(0, 0), a2, voffA);
            PG8_BAR; PG8_WAIT_L(0); PG8_MMA(1, 0, At, B0); PG8_BAR; PG8_SCHED;
            PG8_STAGE(PG8_SB(0, 1), b2 + hstepB, voffB);
            PG8_WAIT_V(6); PG8_BAR; PG8_MMA(1, 1, At, B1); PG8_BAR;
            PG8_LDB(B0, 1, 0); PG8_SCHED; PG8_LDA(At, 1, 0); PG8_STAGE(PG8_SA(0, 1), a2 + hstepA, voffA);
            PG8_WAIT_L(8); PG8_BAR; PG8_WAIT_L(0); PG8_MMA(0, 0, At, B0); PG8_BAR; PG8_SCHED;
            PG8_LDB(B1, 1, 1); PG8_STAGE(PG8_SB(1, 0), b3, voffB);
            PG8_BAR; PG8_WAIT_L(0); PG8_MMA(0, 1, At, B1); PG8_BAR;
            PG8_LDA(At, 1, 1); PG8_STAGE(PG8_SA(1, 0), a3, voffA);
            PG8_BAR; PG8_WAIT_L(0); PG8_MMA(1, 0, At, B0); PG8_BAR; PG8_SCHED;
            PG8_STAGE(PG8_SB(1, 1), b3 + hstepB, voffB);
            PG8_WAIT_V(6); PG8_BAR; PG8_MMA(1, 1, At, B1); PG8_BAR;
            }
        }
        if constexpr (ALIGN_EPI) { if (wr == 0) PG8_BAR; }
        if constexpr (!Epi::AFTER_DRAIN) { E(acc, cur, wr, wc, fr, fq); S.done(cur); }
        if (!has_next) break;
#pragma unroll
        for (int a = 0; a < 2; ++a)
#pragma unroll
            for (int b = 0; b < 2; ++b)
#pragma unroll
                for (int m = 0; m < 4; ++m)
#pragma unroll
                    for (int n = 0; n < 2; ++n) acc[a][b][m][n] = (f32x4){0.f, 0.f, 0.f, 0.f};
        cur = nxt; cA = nA; cB = nB; ++ui;
        if constexpr (ALIGN_EPI) { if (wr == 1) PG8_BAR; }
    }
    PG8_WAIT_V(0);
    if constexpr (!ALIGN_EPI) { if (wr == 0) PG8_BAR; }
    PG8_BAR;
    if constexpr (Epi::AFTER_DRAIN) { E.fused(acc, cur, wr, wc, fr, fq, lds, wid, lane); S.done(cur); }
#undef PG8_SA
#undef PG8_SB
#undef PG8_STAGE
#undef PG8_LDA
#undef PG8_LDB
#undef PG8_MMA
#undef PG8_WAIT_V
#undef PG8_WAIT_L
#undef PG8_BAR
#undef PG8_SCHED
}
}

using pg8::bf16_t; using pg8::bf16x8; using pg8::f32x4; using pg8::u32x4; using pg8::u32x2; using pg8::cvt_pk_bf16; using pg8::bf_lo; using pg8::bf_hi;
typedef float f32x16 __attribute__((ext_vector_type(16)));
#define LAS __attribute__((address_space(3)))

constexpr int NB = 8, S = 4096, T = NB * S, D = 1024, FF = 2816, NMEM = 256;
constexpr int LDZ = 3360, NZP = 3584;
constexpr int ZQ = 0, ZKV = 384, ZKR = 512, ZDQ = 544, ZDK = 1312, ZDV = 2080, ZMQ = 2848;
constexpr float EPS = 1e-6f;
constexpr float LOG2E = 1.4426950408889634f;
constexpr int NWAVES = 8, NTHR = 512;

constexpr size_t MiB = 1u << 20;
constexpr size_t SZ_WGU = (size_t)2 * FF * D * 2, SZ_WD = (size_t)D * FF * 2;
constexpr size_t WS_WGU1 = 0, WS_WD1 = WS_WGU1 + SZ_WGU, WS_WGU2 = WS_WD1 + SZ_WD, WS_WD2 = WS_WGU2 + SZ_WGU;
constexpr size_t WS_WIN = WS_WD2 + SZ_WD, WS_WGATE = WS_WIN + (size_t)NZP * D * 2, WS_WUQ = WS_WGATE + (size_t)3072 * D * 2;
constexpr size_t WS_WUKV = WS_WUQ + (size_t)768 * 384 * 2, WS_WOMLA = WS_WUKV + (size_t)1024 * 128 * 2, WS_WODIL = WS_WOMLA + (size_t)1024 * 768 * 2;
constexpr size_t WS_WMEMKV = WS_WODIL + (size_t)1024 * 256 * 2, WS_WOMEM = WS_WMEMKV + (size_t)1024 * 1024 * 2, WS_WOUT = WS_WOMEM + (size_t)1024 * 512 * 2;
constexpr size_t WS_WEND = WS_WOUT + (size_t)1024 * 1024 * 2;
static_assert(WS_WEND <= 54 * MiB, "weights");
constexpr size_t WS_TABM = 54 * MiB;
constexpr size_t WS_TABD = 58 * MiB;
constexpr size_t WS_LSE = 60 * MiB;
constexpr size_t WS_CTL = 61 * MiB + 768 * 1024;
constexpr size_t WS_MEMKV = 62 * MiB;
constexpr size_t WS_H = 66 * MiB;
constexpr size_t WS_R1 = 130 * MiB;
constexpr size_t WS_QM = 340 * MiB;
constexpr size_t WS_KV = 388 * MiB;
constexpr size_t WS_ODIL = 452 * MiB;
constexpr size_t WS_OMEM = 468 * MiB;
constexpr size_t WS_END = 500 * MiB;
static_assert(WS_R1 + (size_t)T * LDZ * 2 <= WS_QM && WS_R1 + (size_t)T * FF * 2 <= WS_QM && WS_R1 + (size_t)3 * T * D * 2 <= WS_QM, "R1");
static_assert(WS_QM + 128 * MiB <= WS_OMEM, "delta2/3 and x2 (bf16) overlay q | k | v | o_dil");
static_assert(WS_TABM + (size_t)T * 128 <= WS_TABD && WS_TABD + (size_t)T * 64 <= WS_LSE && WS_LSE + (size_t)3 * T * 16 <= WS_CTL && WS_CTL + 16384 <= WS_MEMKV, "tables");

#ifndef PROBE_DBG
#define PROBE_DBG 0
#endif
#ifndef PROBE_DUP
#define PROBE_DUP 0
#endif
constexpr int LDS_BYTES = 147456;

__device__ const float INV_FREQ[16] = {1.000000000e+00f, 4.403665960e-01f, 1.939227432e-01f, 8.539710194e-02f, 3.760603070e-02f, 1.656043902e-02f, 7.292664610e-03f, 3.211445874e-03f,
                                       1.414213562e-03f, 6.227723788e-04f, 2.742481884e-04f, 1.207697351e-04f, 5.318296098e-05f, 2.341999971e-05f, 1.031338616e-05f, 4.541670478e-06f};

struct Args { const float* in[24]; float* out; unsigned char* ws; int ph_lo, ph_hi; };
enum { I_X = 0, I_MEM, I_POS, I_F1N, I_F1G, I_F1U, I_F1D, I_MIXN, I_WIN, I_QN, I_WUQ, I_KVN, I_WUKV, I_WOMLA, I_WODIL, I_MEMN, I_WMEMKV, I_WOMEM, I_WOUT, I_F2N, I_F2G, I_F2U, I_F2D, I_FINN };

__device__ __forceinline__ float wave_sum(float v) {
#pragma unroll
    for (int o = 1; o < 64; o <<= 1) v += __shfl_xor(v, o);
    return v;
}
__device__ __forceinline__ unsigned f2bf(float f) { unsigned u = __builtin_bit_cast(unsigned, f); return (u + 0x7fffu + ((u >> 16) & 1u)) >> 16; }
__device__ __forceinline__ float bf2f(unsigned short h) { return __builtin_bit_cast(float, (unsigned)h << 16); }
__device__ __forceinline__ void sincos_acc(float angf, float& c, float& s) {
    const double a = (double)angf;
    const double k = __builtin_rint(a * 0.63661977236758134308);
    double r = __builtin_fma(-k, 1.57079632679489655800, a); r = __builtin_fma(-k, 6.12323399573676603587e-17, r);
    const int q = (int)((long long)k & 3);
    const double r2 = r * r;
    const double sp = r * (1.0 + r2 * (-1.0 / 6 + r2 * (1.0 / 120 + r2 * (-1.0 / 5040 + r2 * (1.0 / 362880 + r2 * (-1.0 / 39916800))))));
    const double cp = 1.0 + r2 * (-0.5 + r2 * (1.0 / 24 + r2 * (-1.0 / 720 + r2 * (1.0 / 40320 + r2 * (-1.0 / 3628800 + r2 * (1.0 / 479001600))))));
    const double ss = (q & 1) ? cp : sp, cc = (q & 1) ? sp : cp;
    s = (float)((q & 2) ? -ss : ss); c = (float)(((q + 1) & 2) ? -cc : cc);
}

__device__ __forceinline__ void transpose_item(const float* W, int ldw, int col, bf16_t* WT, int ldt, int drow0, int dk0, int k0, LAS float* scr, int lane, bool zgap) {
#pragma unroll 8
    for (int i = 0; i < 32; ++i) { const int kk = 2 * i + (lane >> 5); scr[kk * 33 + (lane & 31)] = W[(size_t)(k0 + kk) * ldw + col + (lane & 31)]; }
    asm volatile("s_waitcnt lgkmcnt(0)" ::: "memory");
    const int c = lane & 7;
#pragma unroll
    for (int j = 0; j < 4; ++j) { const int n = (lane >> 3) + 8 * j; const LAS float* s = scr + (8 * c) * 33 + n;
        u32x4 o; o.x = cvt_pk_bf16(s[0 * 33], s[1 * 33]); o.y = cvt_pk_bf16(s[2 * 33], s[3 * 33]); o.z = cvt_pk_bf16(s[4 * 33], s[5 * 33]); o.w = cvt_pk_bf16(s[6 * 33], s[7 * 33]);
        *(u32x4*)(WT + (size_t)(drow0 + n) * ldt + dk0 + 8 * c) = o; }
    if (zgap) {
#pragma unroll
        for (int j = 0; j < 2; ++j) { const int e = lane + 64 * j, n = e >> 2, ch = e & 3; *(u32x4*)(WT + (size_t)(drow0 + n) * ldt + dk0 + 64 + 8 * ch) = (u32x4){0u, 0u, 0u, 0u}; }
    }
    asm volatile("s_waitcnt lgkmcnt(0)" ::: "memory");
}
struct WD { const float* src; bf16_t* dst; int ldw, col0, ncols, K, ldt, mode; };
constexpr int N_WD = 17;
__device__ __forceinline__ WD wt_desc(int d, __attribute__((address_space(4))) const Args* ap) {
    unsigned char* ws = ap->ws;
    switch (d) {
    case 0: return WD{ap->in[I_F1G], (bf16_t*)(ws + WS_WGU1), FF, 0, FF, D, D, 1};
    case 1: return WD{ap->in[I_F1U], (bf16_t*)(ws + WS_WGU1), FF, 0, FF, D, D, 2};
    case 2: return WD{ap->in[I_F1D], (bf16_t*)(ws + WS_WD1), D, 0, D, FF, FF, 0};
    case 3: return WD{ap->in[I_F2G], (bf16_t*)(ws + WS_WGU2), FF, 0, FF, D, D, 1};
    case 4: return WD{ap->in[I_F2U], (bf16_t*)(ws + WS_WGU2), FF, 0, FF, D, D, 2};
    case 5: return WD{ap->in[I_F2D], (bf16_t*)(ws + WS_WD2), D, 0, D, FF, FF, 0};
    case 6: return WD{ap->in[I_WIN], (bf16_t*)(ws + WS_WIN), 6432, 0, LDZ, D, D, 0};
    case 7: return WD{ap->in[I_WIN], (bf16_t*)(ws + WS_WGATE), 6432, LDZ, 3072, D, D, 0};
    case 8: return WD{ap->in[I_WUQ], (bf16_t*)(ws + WS_WUQ), 768, 0, 768, 384, 384, 0};
    case 9: return WD{ap->in[I_WUKV], (bf16_t*)(ws + WS_WUKV), 1024, 0, 1024, 128, 128, 4};
    case 10: return WD{ap->in[I_WOMLA], (bf16_t*)(ws + WS_WOMLA), 1024, 0, 1024, 512, 512, 0};
    case 11: return WD{ap->in[I_WODIL], (bf16_t*)(ws + WS_WODIL), 1024, 0, 1024, 256, 256, 0};
    case 12: return WD{ap->in[I_WMEMKV], (bf16_t*)(ws + WS_WMEMKV), 1024, 0, 1024, 1024, 1024, 0};
    case 13: return WD{ap->in[I_WOMEM], (bf16_t*)(ws + WS_WOMEM), 1024, 0, 1024, 512, 512, 0};
    case 14: return WD{ap->in[I_WOUT], (bf16_t*)(ws + WS_WOUT), 1024, 0, 1024, 1024, 1024, 0};
    default: return WD{nullptr, nullptr, 0, 0, 0, 0, 0, 0};
    }
}
__device__ __forceinline__ int wt_items(int d) {
    switch (d) {
    case 0: case 1: case 3: case 4: return (D / 64) * (FF / 32);
    case 2: case 5: return (FF / 64) * (D / 32);
    case 6: return (D / 64) * (LDZ / 32);
    case 7: return (D / 64) * (3072 / 32);
    case 8: return (384 / 64) * (768 / 32);
    case 9: return (128 / 64) * (1024 / 32);
    case 10: return (512 / 64) * (1024 / 32);
    case 11: return (256 / 64) * (1024 / 32);
    case 12: return (1024 / 64) * (1024 / 32);
    case 13: return (512 / 64) * (1024 / 32);
    case 14: return (1024 / 64) * (1024 / 32);
    default: return 0;
    }
}
__device__ __forceinline__ bool wt_early(int d) { return d == 0 || d == 1 || d == 12; }
constexpr int WT_EARLY = 2 * (D / 64) * (FF / 32) + (1024 / 64) * (1024 / 32);
constexpr int WT_TOTAL = 4 * (D / 64) * (FF / 32) + 2 * (FF / 64) * (D / 32) + (D / 64) * (LDZ / 32) + (D / 64) * (3072 / 32) + (384 / 64) * (768 / 32) + (128 / 64) * (1024 / 32)
                         + (512 / 64) * (1024 / 32) + (256 / 64) * (1024 / 32) + (1024 / 64) * (1024 / 32) + (512 / 64) * (1024 / 32) + (1024 / 64) * (1024 / 32);
struct WItem { const float* srcp; bf16_t* dstp; int ldw, ldt; bool zgap; };
template <bool EARLY>
__device__ __forceinline__ void wt_decode(int it, __attribute__((address_space(4))) const Args* ap, WItem& I) {
    int r = it, d = 0;
    for (; d < N_WD; ++d) { if (wt_early(d) != EARLY) continue; const int n = wt_items(d); if (r < n) break; r -= n; }
    const WD w = wt_desc(d, ap);
    const int nblk = w.ncols / 32, kb = r / nblk, nb = r % nblk, k0 = 64 * kb, n0 = 32 * nb;
    int drow0 = n0; if (w.mode == 1) drow0 = (n0 >> 7) * 256 + (n0 & 127); else if (w.mode == 2) drow0 = (n0 >> 7) * 256 + 128 + (n0 & 127); else if (w.mode == 4) drow0 = (n0 >> 7) * 64 + (n0 & 63) + ((n0 & 64) ? 512 : 0);
    const int dk0 = (w.mode == 3) ? kb * 96 : k0;
    I.srcp = w.src + (size_t)k0 * w.ldw + w.col0 + n0; I.dstp = w.dst + (size_t)drow0 * w.ldt + dk0; I.ldw = w.ldw; I.ldt = w.ldt; I.zgap = (w.mode == 3);
}
__device__ __forceinline__ void wt_load32(const WItem& I, float (&f)[32], int lane) {
#pragma unroll
    for (int i = 0; i < 32; ++i) f[i] = I.srcp[(size_t)(2 * i + (lane >> 5)) * I.ldw + (lane & 31)];
}
__device__ __forceinline__ void wt_finish(const WItem& I, const float (&f)[32], LAS float* scr, int lane) {
#pragma unroll
    for (int i = 0; i < 32; ++i) scr[(2 * i + (lane >> 5)) * 33 + (lane & 31)] = f[i];
    asm volatile("s_waitcnt lgkmcnt(0)" ::: "memory");
    const int c = lane & 7;
#pragma unroll
    for (int j = 0; j < 4; ++j) { const int n = (lane >> 3) + 8 * j; const LAS float* s = scr + (8 * c) * 33 + n;
        u32x4 o; o.x = cvt_pk_bf16(s[0 * 33], s[1 * 33]); o.y = cvt_pk_bf16(s[2 * 33], s[3 * 33]); o.z = cvt_pk_bf16(s[4 * 33], s[5 * 33]); o.w = cvt_pk_bf16(s[6 * 33], s[7 * 33]);
        *(u32x4*)(I.dstp + (size_t)n * I.ldt + 8 * c) = o; }
    if (I.zgap) {
#pragma unroll
        for (int j = 0; j < 2; ++j) { const int e = lane + 64 * j, n = e >> 2, ch = e & 3; *(u32x4*)(I.dstp + (size_t)n * I.ldt + 64 + 8 * ch) = (u32x4){0u, 0u, 0u, 0u}; }
    }
    asm volatile("s_waitcnt lgkmcnt(0)" ::: "memory");
}
template <bool EARLY>
__device__ __forceinline__ void wt_run(__attribute__((address_space(4))) const Args* ap, LAS float* scr, int lane, int first, int stride, int total) {
    int it = first; if (it >= total) return;
    WItem A, B; float f[32], g[32];
    wt_decode<EARLY>(it, ap, A); wt_load32(A, f, lane);
    for (;;) {
        const int nx = it + stride; const bool has = nx < total;
        if (has) { wt_decode<EARLY>(nx, ap, B); wt_load32(B, g, lane); }
        wt_finish(A, f, scr, lane);
        if (!has) break;
        A = B; it = nx;
#pragma unroll
        for (int i = 0; i < 32; ++i) f[i] = g[i];
    }
}


template <bool OUTF>
__device__ __forceinline__ void rms_row(const float* xrow, const float* g, void* orow, int lane) {
    const f32x4* xr = (const f32x4*)xrow + lane;
    f32x4 v[4]; float s = 0.f;
#pragma unroll
    for (int j = 0; j < 4; ++j) { v[j] = __builtin_nontemporal_load(xr + 64 * j); s += (v[j].x * v[j].x + v[j].y * v[j].y) + (v[j].z * v[j].z + v[j].w * v[j].w); }
    const float rinv = 1.0f / sqrtf(wave_sum(s) * (1.f / 1024.f) + EPS);
#pragma unroll
    for (int j = 0; j < 4; ++j) { const f32x4 gg = ((const f32x4*)g)[lane + 64 * j]; const f32x4 o = v[j] * rinv * gg;
        if (OUTF) ((f32x4*)orow)[lane + 64 * j] = o;
        else { u32x2 w; w.x = cvt_pk_bf16(o.x, o.y); w.y = cvt_pk_bf16(o.z, o.w); ((u32x2*)orow)[lane + 64 * j] = w; } }
}

template <bool XW, bool OUTF>
__device__ __forceinline__ void resid_norm_row(const float* xin, const bf16_t* delta, float* xout, const float* g, void* hout, int lane) {
    const f32x4* xr = (const f32x4*)xin + lane; const u32x2* dr = (const u32x2*)delta + lane;
    f32x4 v[4]; float s = 0.f;
#pragma unroll
    for (int j = 0; j < 4; ++j) { const f32x4 a = xr[64 * j]; const u32x2 d = dr[64 * j];
        v[j] = (f32x4){a.x + bf_lo(d.x), a.y + bf_hi(d.x), a.z + bf_lo(d.y), a.w + bf_hi(d.y)};
        s += (v[j].x * v[j].x + v[j].y * v[j].y) + (v[j].z * v[j].z + v[j].w * v[j].w); }
    const float rinv = 1.0f / sqrtf(wave_sum(s) * (1.f / 1024.f) + EPS);
#pragma unroll
    for (int j = 0; j < 4; ++j) { if (XW) ((f32x4*)xout)[lane + 64 * j] = v[j];
        const f32x4 gg = ((const f32x4*)g)[lane + 64 * j]; const f32x4 o = v[j] * rinv * gg;
        if (OUTF) ((f32x4*)hout)[lane + 64 * j] = o;
        else { u32x2 w; w.x = cvt_pk_bf16(o.x, o.y); w.y = cvt_pk_bf16(o.z, o.w); ((u32x2*)hout)[lane + 64 * j] = w; } }
}

__device__ __forceinline__ void rms_rows4_bf16(const float* x, const float* g, bf16_t* h, size_t m0, size_t mstep, int lane) {
    constexpr int R = 4; f32x4 v[R][4]; float s[R];
#pragma unroll
    for (int r = 0; r < R; ++r) { const f32x4* xr = (const f32x4*)(x + (m0 + r * mstep) * 1024) + lane; s[r] = 0.f;
#pragma unroll
        for (int j = 0; j < 4; ++j) v[r][j] = __builtin_nontemporal_load(xr + 64 * j); }
#pragma unroll
    for (int r = 0; r < R; ++r)
#pragma unroll
        for (int j = 0; j < 4; ++j) s[r] += (v[r][j].x * v[r][j].x + v[r][j].y * v[r][j].y) + (v[r][j].z * v[r][j].z + v[r][j].w * v[r][j].w);
#pragma unroll
    for (int o = 1; o < 64; o <<= 1) {
#pragma unroll
        for (int r = 0; r < R; ++r) s[r] += __shfl_xor(s[r], o); }
#pragma unroll
    for (int r = 0; r < R; ++r) { const float rinv = 1.0f / sqrtf(s[r] * (1.f / 1024.f) + EPS); u32x2* hr = (u32x2*)(h + (m0 + r * mstep) * 1024) + lane;
#pragma unroll
        for (int j = 0; j < 4; ++j) { const f32x4 gg = ((const f32x4*)g)[lane + 64 * j]; const f32x4 o = v[r][j] * rinv * gg; u32x2 w; w.x = cvt_pk_bf16(o.x, o.y); w.y = cvt_pk_bf16(o.z, o.w); hr[64 * j] = w; } }
}

template <bool XINB, bool XW, bool OUTF>
__device__ __forceinline__ void resid_norm_row2(const void* xin, const bf16_t* delta, bf16_t* xout, const float* g, void* hout, size_t m0, size_t mstep, int lane) {
    constexpr int R = 4;
    f32x4 v[R][4]; float s[R];
    f32x4 a[R][4]; u32x2 ab[R][4], d[R][4];
#pragma unroll
    for (int r = 0; r < R; ++r) { const size_t m = m0 + r * mstep; const u32x2* dr = (const u32x2*)(delta + m * 1024) + lane; s[r] = 0.f;
#pragma unroll
        for (int j = 0; j < 4; ++j) { if (XINB) ab[r][j] = __builtin_nontemporal_load((const u32x2*)((const bf16_t*)xin + m * 1024) + lane + 64 * j); else a[r][j] = __builtin_nontemporal_load((const f32x4*)((const float*)xin + m * 1024) + lane + 64 * j); d[r][j] = __builtin_nontemporal_load(dr + 64 * j); } }
#pragma unroll
    for (int r = 0; r < R; ++r)
#pragma unroll
        for (int j = 0; j < 4; ++j) { if (XINB) a[r][j] = (f32x4){bf_lo(ab[r][j].x), bf_hi(ab[r][j].x), bf_lo(ab[r][j].y), bf_hi(ab[r][j].y)};
            v[r][j] = (f32x4){a[r][j].x + bf_lo(d[r][j].x), a[r][j].y + bf_hi(d[r][j].x), a[r][j].z + bf_lo(d[r][j].y), a[r][j].w + bf_hi(d[r][j].y)};
            s[r] += (v[r][j].x * v[r][j].x + v[r][j].y * v[r][j].y) + (v[r][j].z * v[r][j].z + v[r][j].w * v[r][j].w); }
#pragma unroll
    for (int o = 1; o < 64; o <<= 1) {
#pragma unroll
        for (int r = 0; r < R; ++r) s[r] += __shfl_xor(s[r], o); }
#pragma unroll
    for (int r = 0; r < R; ++r) { const size_t m = m0 + r * mstep; const float rinv = 1.0f / sqrtf(s[r] * (1.f / 1024.f) + EPS);
#pragma unroll
        for (int j = 0; j < 4; ++j) { if (XW) { u32x2 w; w.x = cvt_pk_bf16(v[r][j].x, v[r][j].y); w.y = cvt_pk_bf16(v[r][j].z, v[r][j].w); __builtin_nontemporal_store(w, (u32x2*)(xout + m * 1024) + lane + 64 * j); }
            const f32x4 gg = ((const f32x4*)g)[lane + 64 * j]; const f32x4 o = v[r][j] * rinv * gg;
            if (OUTF) __builtin_nontemporal_store(o, (f32x4*)((float*)hout + m * 1024) + lane + 64 * j);
            else { u32x2 w; w.x = cvt_pk_bf16(o.x, o.y); w.y = cvt_pk_bf16(o.z, o.w); ((u32x2*)((bf16_t*)hout + m * 1024))[lane + 64 * j] = w; } } }
}

__device__ __forceinline__ bf16x8 pack_step(const f32x16& x, int s) {
    u32x4 p;
    asm volatile("v_cvt_pk_bf16_f32 %0, %4, %5\n\tv_cvt_pk_bf16_f32 %1, %6, %7\n\tv_cvt_pk_bf16_f32 %2, %8, %9\n\tv_cvt_pk_bf16_f32 %3, %10, %11\n\ts_nop 1"
                 : "=&v"(p[0]), "=&v"(p[1]), "=&v"(p[2]), "=&v"(p[3])
                 : "v"(x[8 * s]), "v"(x[8 * s + 1]), "v"(x[8 * s + 2]), "v"(x[8 * s + 3]), "v"(x[8 * s + 4]), "v"(x[8 * s + 5]), "v"(x[8 * s + 6]), "v"(x[8 * s + 7]));
    return __builtin_bit_cast(bf16x8, p);
}
#define MFMA32(a, b, c) __builtin_amdgcn_mfma_f32_32x32x16_bf16((a), (b), (c), 0, 0, 0)

__device__ __forceinline__ float xhalf_max(float x) { float a = x, b = x; asm volatile("s_nop 1\n\tv_permlane32_swap_b32 %0, %1" : "+v"(a), "+v"(b)); return fmaxf(a, b); }
__device__ __forceinline__ float xhalf_sum(float x) { float a = x, b = x; asm volatile("s_nop 1\n\tv_permlane32_swap_b32 %0, %1" : "+v"(a), "+v"(b)); return a + b; }

template <int DQK, int K1W, int DV, bool BAND, bool SCALE, bool VTG, int TK, int DBG = 0>
__device__ __forceinline__ void attn_unit(LAS unsigned char* lds,
        const bf16_t* qb, size_t qs, const bf16_t* kb, size_t ks, const bf16_t* k2b, size_t k2s, const bf16_t* vb, size_t vs,
        bf16_t* ob, size_t os, float* lseb, size_t lses, int m0, int L, int kt_lo, int kt_hi, float sscale, const int wid_in) {
    constexpr int NSUB = TK / 32, NS = TK / 16;
    constexpr int KROW = DQK + 8, VROW = TK + 4, KCH = DQK / 8, NKC = TK * KCH, VCH = VTG ? TK / 8 : DV / 8, NVC = VTG ? DV * VCH : TK * VCH;
    constexpr int KPT = (NKC + NTHR - 1) / NTHR, VPT = (NVC + NTHR - 1) / NTHR, NKS = DQK / 16, NDT = DV / 32;
    constexpr int VK = (DV == 64) ? 96 : 160;
    constexpr int KBUF = TK * KROW * 2, VBUF = VTG ? DV * VROW * 2 : TK * VK * 2, BUF = KBUF + VBUF;
    static_assert(2 * BUF <= 131072, "attention tiles");
    const int lane = pg8::fresh_lane(), wid = wid_in, tid = wid * 64 + lane, r = lane & 31, hi = lane >> 5;
    const int wq0 = m0 + 32 * wid, q = wq0 + r;
    const float thr = SCALE ? 8.0f / sscale : 8.0f;
    bf16x8 qf[NKS];
#pragma unroll
    for (int k = 0; k < NKS; ++k) qf[k] = *(const bf16x8*)(qb + (size_t)q * qs + 16 * k + 8 * hi);
#pragma unroll
    for (int k = 0; k < NKS; ++k) asm volatile("" :: "v"(qf[k]));
    f32x16 o[NDT], nm;
#pragma unroll
    for (int d = 0; d < NDT; ++d)
#pragma unroll
        for (int i = 0; i < 16; ++i) o[d][i] = 0.f;
#pragma unroll
    for (int i = 0; i < 16; ++i) nm[i] = 0.f;
    float mref = 0.f, lrun = 0.f; bool started = false;
    u32x4 kreg[KPT], vreg[VPT];
#define ATT_LOAD(kt) do { \
    _Pragma("unroll") for (int i = 0; i < KPT; ++i) { const int c = tid + NTHR * i; if (NKC % NTHR == 0 || c < NKC) { const int row = c / KCH, ch = c % KCH; int key = (kt) * TK + row; if (BAND) key = key < 0 ? 0 : (key >= L ? L - 1 : key); \
        const bf16_t* src = (ch * 8 < K1W) ? kb + (size_t)key * ks + ch * 8 : k2b + (size_t)key * k2s + (ch * 8 - K1W); kreg[i] = *(const u32x4*)src; } } \
    _Pragma("unroll") for (int i = 0; i < VPT; ++i) { const int c = tid + NTHR * i; if (NVC % NTHR == 0 || c < NVC) { const int row = c / VCH, ch = c % VCH; \
        if (VTG) vreg[i] = *(const u32x4*)(vb + (size_t)row * vs + (kt) * TK + ch * 8); \
        else { int key = (kt) * TK + row; if (BAND) key = key < 0 ? 0 : (key >= L ? L - 1 : key); vreg[i] = *(const u32x4*)(vb + (size_t)key * vs + ch * 8); } } } } while (0)
#define ATT_WRITE(bi) do { LAS bf16_t* Ks_ = (LAS bf16_t*)(lds + (bi) * BUF); LAS bf16_t* Vt_ = (LAS bf16_t*)(lds + (bi) * BUF + KBUF); \
    _Pragma("unroll") for (int i = 0; i < KPT; ++i) { const int c = tid + NTHR * i; if (NKC % NTHR == 0 || c < NKC) { const int row = c / KCH, ch = c % KCH; *(LAS u32x4*)(Ks_ + row * KROW + ch * 8) = kreg[i]; } } \
    _Pragma("unroll") for (int i = 0; i < VPT; ++i) { const int c = tid + NTHR * i; if (NVC % NTHR == 0 || c < NVC) { const int row = c / VCH, ch = c % VCH; const u32x4 w = vreg[i]; \
        if (VTG) { LAS bf16_t* dst = Vt_ + row * VROW + ch * 8; *(LAS u32x2*)dst = (u32x2){w.x, w.y}; *(LAS u32x2*)(dst + 4) = (u32x2){w.z, w.w}; } \
        else { *(LAS u32x4*)(Vt_ + row * VK + ch * 8) = w; } } } } while (0)
    typedef short s16x4_t __attribute__((ext_vector_type(4)));
    auto vfrag = [&](const LAS bf16_t* Vt, int D_, int S_) -> u32x4 {
        if (VTG) { const LAS bf16_t* vp = Vt + (32 * D_ + r) * VROW + 16 * S_ + 4 * hi; const u32x2 lo = *(const LAS u32x2*)vp, hh = *(const LAS u32x2*)(vp + 8); return (u32x4){lo.x, lo.y, hh.x, hh.y}; }
        else { const int i16 = lane & 15, blk = (lane >> 4) & 1; const LAS bf16_t* vp = Vt + (16 * S_ + 4 * hi + (i16 >> 2)) * VK + 32 * D_ + 16 * blk + 4 * (i16 & 3);
            const s16x4_t lo = __builtin_amdgcn_ds_read_tr16_b64_v4i16((LAS s16x4_t*)vp), hh = __builtin_amdgcn_ds_read_tr16_b64_v4i16((LAS s16x4_t*)(vp + 8 * VK));
            const u32x2 l2 = __builtin_bit_cast(u32x2, lo), h2 = __builtin_bit_cast(u32x2, hh); return (u32x4){l2.x, l2.y, h2.x, h2.y}; } };
#define ATT_VFRAG(D_, S_) vfrag(Vt, (D_), (S_))
    ATT_LOAD(kt_lo);
    ATT_WRITE(0);
    if (kt_lo + 1 < kt_hi) ATT_LOAD(kt_lo + 1);
    if (DBG == 3) { ATT_WRITE(1); }
    __syncthreads();
    for (int kt = kt_lo; kt < kt_hi; ++kt) {
        const int cur = (kt - kt_lo) & 1;
        if (DBG != 3 && kt + 1 < kt_hi) { ATT_WRITE(cur ^ 1); if (kt + 2 < kt_hi) ATT_LOAD(kt + 2); }
        const LAS bf16_t* Ks = (const LAS bf16_t*)(lds + cur * BUF); const LAS bf16_t* Vt = (const LAS bf16_t*)(lds + cur * BUF + KBUF);
        const bool active = !BAND || !((kt * TK + TK - 1 < wq0 - 64) || (kt * TK > wq0 + 31 + 64));
        if (active) {
            f32x16 sc[NSUB];
            {
                bf16x8 ka[2][NSUB];
#pragma unroll
                for (int sub = 0; sub < NSUB; ++sub) ka[0][sub] = *(const LAS bf16x8*)(Ks + (sub * 32 + r) * KROW + 8 * hi);
#pragma unroll
                for (int k = 0; k < NKS; ++k) {
                    if (k + 1 < NKS) {
#pragma unroll
                        for (int sub = 0; sub < NSUB; ++sub) ka[(k + 1) & 1][sub] = *(const LAS bf16x8*)(Ks + (sub * 32 + r) * KROW + 16 * (k + 1) + 8 * hi);
                    }
                    __builtin_amdgcn_sched_barrier(0);
#pragma unroll
                    for (int sub = 0; sub < NSUB; ++sub) sc[sub] = MFMA32(ka[k & 1][sub], qf[k], k == 0 ? nm : sc[sub]);
                    __builtin_amdgcn_sched_barrier(0);
                }
            }
            float mxa[4] = {-INFINITY, -INFINITY, -INFINITY, -INFINITY};
#pragma unroll
            for (int sub = 0; sub < NSUB; ++sub)
#pragma unroll
                for (int i = 0; i < 16; ++i) { float v = sc[sub][i];
                    if (BAND) { const int key = kt * TK + sub * 32 + (i & 3) + 8 * (i >> 2) + 4 * hi; const int dk = key - q; const bool ok = (key >= 0) && (key < L) && (dk <= 64) && (dk >= -64); v = ok ? v : -INFINITY; sc[sub][i] = v; }
                    mxa[i & 3] = fmaxf(mxa[i & 3], v); }
            const float mx = xhalf_max(fmaxf(fmaxf(mxa[0], mxa[1]), fmaxf(mxa[2], mxa[3])));
            const bool adopt = started ? (mx > thr) : (mx > -INFINITY);
            if (__builtin_amdgcn_ballot_w64(adopt) != 0ull) {
                const float delta = adopt ? mx : 0.f;
                const float alpha = started ? __builtin_amdgcn_exp2f(SCALE ? -delta * sscale : -delta) : 1.0f;
#pragma unroll
                for (int sub = 0; sub < NSUB; ++sub)
#pragma unroll
                    for (int i = 0; i < 16; ++i) sc[sub][i] -= delta;
#pragma unroll
                for (int d = 0; d < NDT; ++d)
#pragma unroll
                    for (int i = 0; i < 16; ++i) o[d][i] *= alpha;
                lrun *= alpha; mref += delta; started = started || adopt;
#pragma unroll
                for (int i = 0; i < 16; ++i) nm[i] = -mref;
            }
            float rsa[4] = {0.f, 0.f, 0.f, 0.f};
#pragma unroll
            for (int sub = 0; sub < NSUB; ++sub)
#pragma unroll
                for (int i = 0; i < 16; ++i) { if (DBG == 1) { rsa[i & 3] = 1.f; } else { const float p = __builtin_amdgcn_exp2f(SCALE ? sc[sub][i] * sscale : sc[sub][i]); sc[sub][i] = p; rsa[i & 3] += p; } }
            lrun += (rsa[0] + rsa[1]) + (rsa[2] + rsa[3]);
            {
                u32x4 va[2][NDT];
#pragma unroll
                for (int d = 0; d < NDT; ++d) va[0][d] = ATT_VFRAG(d, 0);
#pragma unroll
                for (int s = 0; s < NS; ++s) {
                    if (s + 1 < NS) {
#pragma unroll
                        for (int d = 0; d < NDT; ++d) va[(s + 1) & 1][d] = ATT_VFRAG(d, s + 1);
                    }
                    const bf16x8 pf = pack_step(sc[s >> 1], s & 1);
                    __builtin_amdgcn_sched_barrier(0);
#pragma unroll
                    for (int d = 0; d < NDT; ++d) o[d] = MFMA32(__builtin_bit_cast(bf16x8, va[s & 1][d]), pf, o[d]);
                    __builtin_amdgcn_sched_barrier(0);
                }
            }
        }
        __syncthreads();
    }
#undef ATT_LOAD
#undef ATT_WRITE
#undef ATT_VFRAG
    const float lsum = xhalf_sum(lrun);
    const float inv = 1.0f / lsum;
#pragma unroll
    for (int d = 0; d < NDT; ++d)
#pragma unroll
        for (int g = 0; g < 4; ++g) { u32x2 w; w.x = cvt_pk_bf16(o[d][4 * g] * inv, o[d][4 * g + 1] * inv); w.y = cvt_pk_bf16(o[d][4 * g + 2] * inv, o[d][4 * g + 3] * inv);
            *(u32x2*)(ob + (size_t)q * os + 32 * d + 8 * g + 4 * hi) = w; }
    if (BAND) { if (hi == 0) lseb[(size_t)q * lses] = (SCALE ? mref * sscale : mref) + __builtin_amdgcn_logf(lsum); }
}

__device__ __forceinline__ bool xb_is_t0(int w) { return w == 0 && pg8::fresh_lane() == 0; }
#define XB_TMO      128
#define XB_XCNT(j)  (256  + 64 * (j))
#define XB_XSUB(j)  (1280 + 64 * (j))
#define XB_XGEN(j)  (2304 + 64 * (j))
#define XB_TOP      3328
#define XB_TOPGEN   3392
#define XCD_BAR_WORDS 3456
#define XB_SPIN_CAP (1u << 18)

__device__ __forceinline__ unsigned xb_ld(unsigned* p)              { return __hip_atomic_load(p, __ATOMIC_RELAXED, __HIP_MEMORY_SCOPE_AGENT); }
__device__ __forceinline__ unsigned xb_add(unsigned* p, unsigned v) { return __hip_atomic_fetch_add(p, v, __ATOMIC_RELAXED, __HIP_MEMORY_SCOPE_AGENT); }
__device__ __forceinline__ unsigned xb_xcc_id() { return (unsigned)__builtin_amdgcn_s_getreg((3 << 11) | 20) & 0xFu; }
#define XB_SPIN(cond, bar) do { unsigned _sp = 0; while (cond) { __builtin_amdgcn_s_sleep(1); \
    if ((++_sp & 255u) == 0u) { if (xb_ld(&(bar)[XB_TMO])) break; if (_sp > XB_SPIN_CAP) { atomicAdd(&(bar)[XB_TMO], 1u); break; } } } } while (0)

struct XcdBarrier {
    unsigned* bar; unsigned x;
    volatile LAS unsigned* st;
};

__device__ __forceinline__ XcdBarrier xcd_barrier_post(unsigned* bar, volatile LAS unsigned* st, const int b_wave) {
    XcdBarrier b; b.bar = bar; b.x = xb_xcc_id(); b.st = st;
    if (xb_is_t0(b_wave)) (void)xb_add(&bar[XB_XCNT(b.x)], 1u);
    return b;
}
__device__ __forceinline__ void xcd_barrier_complete(unsigned* bar, unsigned x, unsigned& nloc, unsigned& nx) {
    const unsigned G = gridDim.x * gridDim.y * gridDim.z;
    unsigned sum, cnt, mine, sp = 0u;
    for (;;) {
        sum = 0u; cnt = 0u; mine = 0u;
#pragma unroll
        for (unsigned j = 0; j < 16; ++j) { const unsigned c = xb_ld(&bar[XB_XCNT(j)]); sum += c; cnt += (c > 0u) ? 1u : 0u; mine = (j == x) ? c : mine; }
        if (sum == G) break;
        __builtin_amdgcn_s_sleep(1);
        if ((++sp & 255u) == 0u) { if (xb_ld(&bar[XB_TMO])) break; if (sp > XB_SPIN_CAP) { atomicAdd(&bar[XB_TMO], 1u); break; } }
    }
    nloc = mine > 0u ? mine : 1u; nx = cnt > 0u ? cnt : 1u;
}

__device__ __forceinline__ void xcd_barrier(const XcdBarrier& b, const int b_wave) {
    asm volatile("s_waitcnt vmcnt(0)" ::: "memory");
    __syncthreads();
    if (xb_is_t0(b_wave)) {
        unsigned* bar = b.bar;
        __builtin_amdgcn_s_waitcnt(0);
        unsigned nloc = b.st[0], nx = b.st[1];
        if (nloc == 0u) { xcd_barrier_complete(bar, b.x, nloc, nx); b.st[0] = nloc; b.st[1] = nx; }
        const unsigned old = xb_add(&bar[XB_XSUB(b.x)], 1u);
        const unsigned gen = old / nloc;
        if (old + 1u == (gen + 1u) * nloc) {
            __builtin_amdgcn_fence(__ATOMIC_RELEASE, "agent");
            asm volatile("s_waitcnt vmcnt(0)" ::: "memory");
            const unsigned og = xb_add(&bar[XB_TOP], 1u);
            const unsigned tg = og / nx;
            if (og + 1u == (tg + 1u) * nx) xb_add(&bar[XB_TOPGEN], 1u);
            else XB_SPIN(xb_ld(&bar[XB_TOPGEN]) == tg, bar);
            __builtin_amdgcn_fence(__ATOMIC_ACQUIRE, "agent");
            xb_add(&bar[XB_XGEN(b.x)], 1u);
            asm volatile("s_waitcnt vmcnt(0)" ::: "memory");
        } else {
            XB_SPIN(xb_ld(&bar[XB_XGEN(b.x)]) == gen, bar);
            __builtin_amdgcn_fence(__ATOMIC_ACQUIRE, "agent");
            asm volatile("s_waitcnt vmcnt(0)" ::: "memory");
        }
    }
    __syncthreads();
}

__global__ void __launch_bounds__(NTHR, 2) mk_fwd(Args args) {
    extern __shared__ __attribute__((aligned(16))) unsigned char lds_raw[];
    LAS unsigned char* lds = (LAS unsigned char*)lds_raw;
    cg::grid_group grid = cg::this_grid();
    const int wave = __builtin_amdgcn_readfirstlane((int)threadIdx.x >> 6);
    const int cu = blockIdx.x;
    typedef __attribute__((address_space(4))) const Args CArgs;
    const int lo = ((CArgs*)__builtin_amdgcn_kernarg_segment_ptr())->ph_lo, hi = ((CArgs*)__builtin_amdgcn_kernarg_segment_ptr())->ph_hi;
    (void)args;
#define IN(k) (lo <= (k) && (k) < hi)
    volatile LAS unsigned* xst = (volatile LAS unsigned*)(lds + 131072);
    if (xb_is_t0(wave)) { xst[0] = 0u; xst[1] = 0u; }
    __syncthreads();
    (void)xcd_barrier_post((unsigned*)(((CArgs*)__builtin_amdgcn_kernarg_segment_ptr())->ws + WS_CTL), xst, wave);
    if (hi > 1000) grid.sync();
#define SEAM(k) do { if (IN(k) && IN((k) + 1)) { XcdBarrier xb_; xb_.bar = (unsigned*)(((CArgs*)__builtin_amdgcn_kernarg_segment_ptr())->ws + WS_CTL); xb_.x = xb_xcc_id(); xb_.st = xst; xcd_barrier(xb_, wave); \
    if (PROBE_DUP == 30) xcd_barrier(xb_, wave); } } while (0)
#define PH_VARS CArgs* ap = (CArgs*)__builtin_amdgcn_kernarg_segment_ptr(); asm volatile("" : "+s"(ap)); \
    const int G = gridDim.x, NGW = G * NWAVES; const long NGT = (long)G * NTHR; \
    const int lane = pg8::fresh_lane(), tid = wave * 64 + lane; const int gw = cu * NWAVES + wave; const long gt = (long)cu * NTHR + tid; \
    unsigned char* ws = ap->ws; const float* x = ap->in[I_X]; float* out = ap->out; \
    bf16_t* H = (bf16_t*)(ws + WS_H); bf16_t* U = (bf16_t*)(ws + WS_R1); bf16_t* Z = (bf16_t*)(ws + WS_R1); bf16_t* Y = (bf16_t*)(ws + WS_R1); \
    bf16_t* QM = (bf16_t*)(ws + WS_QM); bf16_t* MEMN = (bf16_t*)(ws + WS_QM); bf16_t* KV = (bf16_t*)(ws + WS_KV); bf16_t* MEMKV = (bf16_t*)(ws + WS_MEMKV); \
    bf16_t* X1B = (bf16_t*)out; bf16_t* OMLA = (bf16_t*)((unsigned char*)out + 64 * MiB); bf16_t* DL2 = (bf16_t*)(ws + WS_QM); bf16_t* X2B = (bf16_t*)(ws + WS_QM + 64 * MiB); bf16_t* ODIL = (bf16_t*)(ws + WS_ODIL); bf16_t* OMEM = (bf16_t*)(ws + WS_OMEM); \
    float* TABM = (float*)(ws + WS_TABM); float* TABD = (float*)(ws + WS_TABD); float* LSE = (float*)(ws + WS_LSE); \
    (void)NGW; (void)NGT; (void)lane; (void)tid; (void)gw; (void)gt; (void)x; (void)out; (void)H; (void)U; (void)Z; (void)Y; (void)QM; (void)MEMN; (void)KV; (void)MEMKV; (void)X1B; (void)OMLA; (void)DL2; (void)X2B; (void)ODIL; (void)OMEM; (void)TABM; (void)TABD; (void)LSE

    if (IN(0)) for (int rep_ = 0; rep_ < (PROBE_DUP == 4 ? 2 : 1); ++rep_) {
        PH_VARS;
        LAS float* scr = (LAS float*)(lds + wave * 16384);
        wt_run<true>(ap, scr, lane, gw, NGW, WT_EARLY);
        {
            const int* pos = (const int*)ap->in[I_POS];
            for (long i = gt; i < (long)T * 24; i += NGT) { const int t = (int)(i / 24), f = (int)(i % 24);
                const float inv = f < 16 ? INV_FREQ[f] : INV_FREQ[2 * (f - 16)];
                const float ang = (float)pos[t] * inv; float c, s; sincos_acc(ang, c, s);
                float* dst = f < 16 ? TABM + (size_t)t * 32 + 2 * f : TABD + (size_t)t * 16 + 2 * (f - 16); dst[0] = c; dst[1] = s; }
        }
        for (int m = gw; m < T; m += 4 * NGW) rms_rows4_bf16(x, ap->in[I_F1N], H, (size_t)m, (size_t)NGW, lane);
        for (int m = gw; m < NB * NMEM; m += NGW) rms_row<false>(ap->in[I_MEM] + (size_t)m * D, ap->in[I_MEMN], MEMN + (size_t)m * D, lane);
        __syncthreads();
    }
    SEAM(0);
    if (IN(1)) for (int rep_ = 0; rep_ < (PROBE_DUP == 5 ? 2 : 1); ++rep_) {
        PH_VARS;
        { pg8::Gemm g{H, (const bf16_t*)(ws + WS_WGU1), T, 2 * FF, D, D, D}; pg8::StaticOrder so; so.init(T, 2 * FF, G, cu);
          pg8::EpiSwiglu E{U, FF}; pg8::gemm_phase<pg8::EpiSwiglu, pg8::StaticOrder, true, true>(lds, g, so, E, wave); }
        { pg8::Gemm g{MEMN, (const bf16_t*)(ws + WS_WMEMKV), NB * NMEM, 1024, D, D, D}; pg8::StaticOrder so; so.init(NB * NMEM, 1024, G, cu);
          pg8::EpiBf16 E{MEMKV, 1024, 1024, 1.0f, false}; pg8::gemm_phase<pg8::EpiBf16, pg8::StaticOrder, true, true>(lds, g, so, E, wave); }
        if (cu >= (NB * NMEM / 256) * 4) {
            const int nb0 = (NB * NMEM / 256) * 4, gw2 = (cu - nb0) * NWAVES + wave, NGW2 = (G - nb0) * NWAVES; const long gt2 = (long)(cu - nb0) * NTHR + tid, NGT2 = (long)(G - nb0) * NTHR;
            LAS float* scr = (LAS float*)(lds + wave * 16384);
            wt_run<false>(ap, scr, lane, gw2, NGW2, WT_TOTAL - WT_EARLY);
            {
                u32x4* p = (u32x4*)(ws + WS_WIN + (size_t)LDZ * D * 2); const long n = (long)(NZP - LDZ) * D * 2 / 16;
                for (long i = gt2; i < n; i += NGT2) p[i] = (u32x4){0u, 0u, 0u, 0u};
            }
            __syncthreads();
        }
    }
    SEAM(1);
    if (IN(2)) for (int rep_ = 0; rep_ < (PROBE_DUP == 12 ? 2 : 1); ++rep_) {
        PH_VARS;
        pg8::Gemm g{U, (const bf16_t*)(ws + WS_WD1), T, D, FF, FF, FF}; pg8::StaticOrder so; so.init(T, D, G, cu);
        pg8::EpiBf16 E{KV, D, D, 0.5f, false}; pg8::gemm_phase<pg8::EpiBf16, pg8::StaticOrder, true, true>(lds, g, so, E, wave);
    }
    SEAM(2);
    if (IN(3)) for (int rep_ = 0; rep_ < (PROBE_DUP == 13 ? 2 : 1); ++rep_) { PH_VARS; for (int m = gw; m < T; m += 4 * NGW) resid_norm_row2<false, true, false>(x, KV, X1B, ap->in[I_MIXN], H, (size_t)m, (size_t)NGW, lane); }
    SEAM(3);
    if (IN(4)) for (int rep_ = 0; rep_ < (PROBE_DUP == 14 ? 2 : 1); ++rep_) {
        PH_VARS;
        pg8::Gemm g{H, (const bf16_t*)(ws + WS_WIN), T, NZP, D, D, D}; pg8::StaticOrder so; so.init(T, NZP, G, cu);
        pg8::EpiBf16 E{Z, LDZ, LDZ, 1.0f, false}; pg8::gemm_phase<pg8::EpiBf16, pg8::StaticOrder, true, true>(lds, g, so, E, wave);
    }
    SEAM(4);
    if (IN(5)) {
        PH_VARS;
        const float* qn = ap->in[I_QN]; const float* kvn = ap->in[I_KVN];
        const float* gp = lane < 48 ? qn + lane * 8 : kvn + (lane - 48) * 8;
        const f32x4 g0 = *(const f32x4*)gp, g1 = *(const f32x4*)(gp + 4);
        const bool dl = lane < 24, kl = (lane >= 32 && lane < 36);
        const int hoff = (lane < 12 ? ZDQ : ZDK) + (lane < 12 ? lane : lane - 12) * 64, j4 = (lane & 3) * 4;
        for (int t0 = gw; t0 < T; t0 += 4 * NGW) {
            u32x4 w[4], ra[4], rb[4]; u32x2 ka[4], kb[4]; f32x4 tb[4][4];
#pragma unroll
            for (int u = 0; u < 4; ++u) { const int t = t0 + u * NGW; if (t < T) { const bf16_t* zr = Z + (size_t)t * LDZ;
                w[u] = *(const u32x4*)(zr + lane * 8);
                if (dl) { ra[u] = *(const u32x4*)(zr + hoff); rb[u] = *(const u32x4*)(zr + hoff + 8);
#pragma unroll
                    for (int i = 0; i < 4; ++i) tb[u][i] = *(const f32x4*)(TABD + (size_t)t * 16 + 4 * i); }
                else if (kl) { ka[u] = *(const u32x2*)(zr + ZKR + j4); kb[u] = *(const u32x2*)(zr + ZKR + 16 + j4); tb[u][0] = *(const f32x4*)(TABM + (size_t)t * 32 + 2 * j4); tb[u][1] = *(const f32x4*)(TABM + (size_t)t * 32 + 2 * j4 + 4); } } }
#pragma unroll
            for (int u = 0; u < 4; ++u) { const int t = t0 + u * NGW; if (t < T) { bf16_t* zr = Z + (size_t)t * LDZ;
                const float f[8] = {bf_lo(w[u].x), bf_hi(w[u].x), bf_lo(w[u].y), bf_hi(w[u].y), bf_lo(w[u].z), bf_hi(w[u].z), bf_lo(w[u].w), bf_hi(w[u].w)};
                float ss = 0.f;
#pragma unroll
                for (int j = 0; j < 8; ++j) ss += f[j] * f[j];
#pragma unroll
                for (int o = 1; o < 16; o <<= 1) ss += __shfl_xor(ss, o);
                float tot = ss; tot += __shfl_xor(tot, 16); tot += __shfl_xor(tot, 32);
                const float skv = __builtin_bit_cast(float, __builtin_amdgcn_readlane(__builtin_bit_cast(int, ss), 63)), sq = tot - skv;
                const float rinv = lane < 48 ? 1.0f / sqrtf(sq * (1.f / 384.f) + EPS) : 1.0f / sqrtf(skv * (1.f / 128.f) + EPS);
                u32x4 o; o.x = cvt_pk_bf16(f[0] * rinv * g0.x, f[1] * rinv * g0.y); o.y = cvt_pk_bf16(f[2] * rinv * g0.z, f[3] * rinv * g0.w);
                o.z = cvt_pk_bf16(f[4] * rinv * g1.x, f[5] * rinv * g1.y); o.w = cvt_pk_bf16(f[6] * rinv * g1.z, f[7] * rinv * g1.w);
                *(u32x4*)(zr + lane * 8) = o;
                if (dl) {
                    const u32x4 a = ra[u], b = rb[u]; const f32x4 t0_ = tb[u][0], t1 = tb[u][1], t2 = tb[u][2], t3 = tb[u][3];
                    const float x1[8] = {bf_lo(a.x), bf_hi(a.x), bf_lo(a.y), bf_hi(a.y), bf_lo(a.z), bf_hi(a.z), bf_lo(a.w), bf_hi(a.w)};
                    const float x2[8] = {bf_lo(b.x), bf_hi(b.x), bf_lo(b.y), bf_hi(b.y), bf_lo(b.z), bf_hi(b.z), bf_lo(b.w), bf_hi(b.w)};
                    const float cs[8] = {t0_.x, t0_.z, t1.x, t1.z, t2.x, t2.z, t3.x, t3.z}, sn[8] = {t0_.y, t0_.w, t1.y, t1.w, t2.y, t2.w, t3.y, t3.w};
                    float y1[8], y2[8];
#pragma unroll
                    for (int i = 0; i < 8; ++i) { y1[i] = x1[i] * cs[i] - x2[i] * sn[i]; y2[i] = x2[i] * cs[i] + x1[i] * sn[i]; }
                    u32x4 oa, ob; oa.x = cvt_pk_bf16(y1[0], y1[1]); oa.y = cvt_pk_bf16(y1[2], y1[3]); oa.z = cvt_pk_bf16(y1[4], y1[5]); oa.w = cvt_pk_bf16(y1[6], y1[7]);
                    ob.x = cvt_pk_bf16(y2[0], y2[1]); ob.y = cvt_pk_bf16(y2[2], y2[3]); ob.z = cvt_pk_bf16(y2[4], y2[5]); ob.w = cvt_pk_bf16(y2[6], y2[7]);
                    *(u32x4*)(zr + hoff) = oa; *(u32x4*)(zr + hoff + 8) = ob;
                } else if (kl) {
                    const u32x2 a = ka[u], b = kb[u]; const f32x4 t0_ = tb[u][0], t1 = tb[u][1];
                    const float x1[4] = {bf_lo(a.x), bf_hi(a.x), bf_lo(a.y), bf_hi(a.y)}, x2[4] = {bf_lo(b.x), bf_hi(b.x), bf_lo(b.y), bf_hi(b.y)};
                    const float cs[4] = {t0_.x, t0_.z, t1.x, t1.z}, sn[4] = {t0_.y, t0_.w, t1.y, t1.w};
                    float y1[4], y2[4];
#pragma unroll
                    for (int i = 0; i < 4; ++i) { y1[i] = x1[i] * cs[i] - x2[i] * sn[i]; y2[i] = x2[i] * cs[i] + x1[i] * sn[i]; }
                    u32x2 oa, ob; oa.x = cvt_pk_bf16(y1[0], y1[1]); oa.y = cvt_pk_bf16(y1[2], y1[3]); ob.x = cvt_pk_bf16(y2[0], y2[1]); ob.y = cvt_pk_bf16(y2[2], y2[3]);
                    *(u32x2*)(zr + ZKR + j4) = oa; *(u32x2*)(zr + ZKR + 16 + j4) = ob;
                } } }
        }
    }
    SEAM(5);
    if (IN(6)) {
        PH_VARS;
        for (int rep6_ = 0; rep6_ < (PROBE_DUP == 40 ? 2 : 1); ++rep6_) {
        { pg8::Gemm g{Z + ZQ, (const bf16_t*)(ws + WS_WUQ), T, 768, 384, LDZ, 384}; pg8::StaticOrder so; so.init(T, 768, G, cu);
          pg8::EpiQRope E{QM, 768, TABM, 0.10206207261596575f * LOG2E}; pg8::gemm_phase<pg8::EpiQRope, pg8::StaticOrder, true, true>(lds, g, so, E, wave); }
        { pg8::Gemm g{Z + ZKV, (const bf16_t*)(ws + WS_WUKV), T, 512, 128, LDZ, 128}; pg8::StaticOrder so; so.init(T, 512, G, cu);
          pg8::EpiBf16 E{KV, 512, 512, 1.0f, false}; pg8::gemm_phase<pg8::EpiBf16, pg8::StaticOrder, true, true>(lds, g, so, E, wave); }
        { pg8::Gemm g{(const bf16_t*)(ws + WS_WUKV) + 512 * 128, Z + ZKV, 512, T, 128, 128, LDZ}; pg8::StaticOrder so; so.init(512, T, G, cu);
          pg8::EpiBf16 E{KV + (size_t)T * 512, T, T, 1.0f, false}; pg8::gemm_phase<pg8::EpiBf16, pg8::StaticOrder, true, true>(lds, g, so, E, wave); }
        }
        for (int u0 = cu; u0 < NB * 12 * 16; u0 += G) {
            int u = u0; if ((G & 127) == 0) { const int rnd_ = u0 / G, c_ = u0 % G, xcd_ = c_ & 7, slot_ = c_ >> 3, per_ = G >> 7; u = (rnd_ * (G >> 4) + xcd_ * per_ + (slot_ >> 4)) * 16 + (slot_ & 15); }
            const int b = u / 192, rem = u % 192, gh = rem / 16, i16 = rem % 16, g = gh >> 2, h = gh & 3;
            const int dil = (g == 0) ? 1 : (g == 1 ? 4 : 16), L = S / dil, bpc = 16 / dil, rr = i16 / bpc, mb = i16 % bpc, m0 = mb * 256;
            bf16_t* base = Z + (size_t)(b * S + rr) * LDZ + gh * 64; const size_t st = (size_t)dil * LDZ;
            int kt_lo = m0 / 64 - 1, kt_hi = m0 / 64 + 5; if (kt_lo < 0) kt_lo = 0; if (kt_hi > L / 64) kt_hi = L / 64;
            float* lb = LSE + (size_t)g * T * 4 + (size_t)(b * S + rr) * 4 + h;
            attn_unit<64, 64, 64, true, true, false, 64>(lds, base + ZDQ, st, base + ZDK, st, base + ZDK, st, base + ZDV, st, base + ZDQ, st, lb, (size_t)dil * 4, m0, L, kt_lo, kt_hi, 0.125f * LOG2E, wave);
        }
#if PROBE_DUP == 2
        for (int u = cu; u < NB * 12 * 16; u += G) {
            const int b = u / 192, rem = u % 192, gh = rem / 16, i16 = rem % 16, g = gh >> 2, h = gh & 3;
            const int dil = (g == 0) ? 1 : (g == 1 ? 4 : 16), L = S / dil, bpc = 16 / dil, rr = i16 / bpc, mb = i16 % bpc, m0 = mb * 256;
            bf16_t* base = Z + (size_t)(b * S + rr) * LDZ + gh * 64; const size_t st = (size_t)dil * LDZ;
            int kt_lo = m0 / 64 - 1, kt_hi = m0 / 64 + 5; if (kt_lo < 0) kt_lo = 0; if (kt_hi > L / 64) kt_hi = L / 64;
            attn_unit<64, 64, 64, true, true, false, 64>(lds, base + ZDQ, st, base + ZDK, st, base + ZDK, st, base + ZDV, st, ODIL + (size_t)cu * 16384 - (size_t)m0 * 64, 64, (float*)(ODIL + (size_t)4194304) + cu * 256 - m0, 1, m0, L, kt_lo, kt_hi, 0.125f * LOG2E, wave);
            (void)h;
        }
#endif
        for (int u0 = cu; u0 < NB * 4 * 16; u0 += G) {
            int u = u0; if ((G & 127) == 0) { const int rnd_ = u0 / G, c_ = u0 % G, xcd_ = c_ & 7, slot_ = c_ >> 3, per_ = G >> 7; u = (rnd_ * (G >> 4) + xcd_ * per_ + (slot_ >> 4)) * 16 + (slot_ & 15); }
            const int b = u / 64, h = (u / 16) % 4, qb = u % 16;
            const bf16_t* kbase = MEMKV + (size_t)b * NMEM * 1024 + h * 128;
            attn_unit<128, 128, 128, false, true, false, 64>(lds, Z + (size_t)b * S * LDZ + ZMQ + h * 128, LDZ, kbase, 1024, kbase, 1024, kbase + 512, 1024,
                                                  OMEM + (size_t)b * S * 512 + h * 128, 512, nullptr, 0, qb * 256, NMEM, 0, NMEM / 64, 0.08838834764831845f * LOG2E, wave);
        }
#if PROBE_DUP == 3
        for (int u = cu; u < NB * 4 * 16; u += G) {
            const int b = u / 64, h = (u / 16) % 4, qb = u % 16;
            const bf16_t* kbase = MEMKV + (size_t)b * NMEM * 1024 + h * 128;
            attn_unit<128, 128, 128, false, true, false, 64>(lds, Z + (size_t)b * S * LDZ + ZMQ + h * 128, LDZ, kbase, 1024, kbase, 1024, kbase + 512, 1024,
                                                  OMEM + (size_t)b * S * 512 + h * 128, 512, nullptr, 0, qb * 256, NMEM, 0, NMEM / 64, 0.08838834764831845f * LOG2E, wave);
        }
#endif
        __syncthreads();
    }
    SEAM(6);
    if (IN(7)) {
        PH_VARS;
        {
            const int h = lane >> 4, d0 = (lane & 15) * 4;
            for (int t0 = gw; t0 < T; t0 += 4 * NGW) {
                float l[4][3]; u32x2 wv[4][3];
#pragma unroll
                for (int u = 0; u < 4; ++u) { const int t = t0 + u * NGW; if (t < T) {
#pragma unroll
                    for (int g = 0; g < 3; ++g) { l[u][g] = LSE[(size_t)g * T * 4 + (size_t)t * 4 + h]; wv[u][g] = *(const u32x2*)(Z + (size_t)t * LDZ + ZDQ + (g * 4 + h) * 64 + d0); } } }
#pragma unroll
                for (int u = 0; u < 4; ++u) { const int t = t0 + u * NGW; if (t < T) {
                    const float mx = fmaxf(l[u][0], fmaxf(l[u][1], l[u][2]));
                    const float e0 = __builtin_amdgcn_exp2f(l[u][0] - mx), e1 = __builtin_amdgcn_exp2f(l[u][1] - mx), e2 = __builtin_amdgcn_exp2f(l[u][2] - mx), inv = 1.0f / (e0 + e1 + e2);
                    const float r0 = (e0 * bf_lo(wv[u][0].x) + e1 * bf_lo(wv[u][1].x) + e2 * bf_lo(wv[u][2].x)) * inv, r1 = (e0 * bf_hi(wv[u][0].x) + e1 * bf_hi(wv[u][1].x) + e2 * bf_hi(wv[u][2].x)) * inv;
                    const float r2 = (e0 * bf_lo(wv[u][0].y) + e1 * bf_lo(wv[u][1].y) + e2 * bf_lo(wv[u][2].y)) * inv, r3 = (e0 * bf_hi(wv[u][0].y) + e1 * bf_hi(wv[u][1].y) + e2 * bf_hi(wv[u][2].y)) * inv;
                    u32x2 w; w.x = cvt_pk_bf16(r0, r1); w.y = cvt_pk_bf16(r2, r3);
                    *(u32x2*)(ODIL + (size_t)t * 256 + h * 64 + d0) = w; } }
            }
        }
        for (int u0 = cu; u0 < NB * 8 * 16; u0 += G) {
            int u = u0; if ((G & 127) == 0) { const int rnd_ = u0 / G, c_ = u0 % G, xcd_ = c_ & 7, slot_ = c_ >> 3, per_ = G >> 7; u = (rnd_ * (G >> 4) + xcd_ * per_ + (slot_ >> 4)) * 16 + (slot_ & 15); }
            const int b = u / 128, h = (u / 16) % 8, qb = u % 16;
            bf16_t* qbase = QM + (size_t)b * S * 768 + h * 96;
            const bf16_t* kbase = KV + (size_t)b * S * 512 + h * 64; const bf16_t* vtb = KV + (size_t)T * 512 + (size_t)(h * 64) * T + (size_t)b * S;
            attn_unit<96, 64, 64, false, false, true, 128>(lds, qbase, 768, kbase, 512, Z + (size_t)b * S * LDZ + ZKR, LDZ, vtb, T, OMLA + (size_t)b * S * 512 + h * 64, 512, nullptr, 0, qb * 256, S, 0, S / 128, 1.0f, wave);
        }
#if PROBE_DUP == 1
        for (int u = cu; u < NB * 8 * 16; u += G) {
            const int b = u / 128, h = (u / 16) % 8, qb = u % 16;
            bf16_t* qbase = QM + (size_t)b * S * 768 + h * 96;
            const bf16_t* kbase = KV + (size_t)b * S * 512 + h * 64; const bf16_t* vtb = KV + (size_t)T * 512 + (size_t)(h * 64) * T + (size_t)b * S;
            attn_unit<96, 64, 64, false, false, true, 128, PROBE_DBG>(lds, qbase, 768, kbase, 512, Z + (size_t)b * S * LDZ + ZKR, LDZ, vtb, T, MEMKV + (size_t)(cu & 127) * 16384 - (size_t)qb * 256 * 64, 64, nullptr, 0, qb * 256, S, 0, S / 128, 1.0f, wave);
        }
#endif
        __syncthreads();
    }
    SEAM(7);
    if (IN(8)) for (int rep_ = 0; rep_ < (PROBE_DUP == 18 ? 2 : 1); ++rep_) {
        PH_VARS;
        { pg8::Gemm g{OMLA, (const bf16_t*)(ws + WS_WOMLA), T, D, 512, 512, 512}; pg8::StaticOrder so; so.init(T, D, G, cu);
          pg8::EpiBf16 E{Y, D, D, 1.0f, true}; pg8::gemm_phase<pg8::EpiBf16, pg8::StaticOrder, true, true>(lds, g, so, E, wave); }
        { pg8::Gemm g{ODIL, (const bf16_t*)(ws + WS_WODIL), T, D, 256, 256, 256}; pg8::StaticOrder so; so.init(T, D, G, cu);
          pg8::EpiBf16 E{Y + (size_t)T * D, D, D, 1.0f, true}; pg8::gemm_phase<pg8::EpiBf16, pg8::StaticOrder, true, true>(lds, g, so, E, wave); }
        { pg8::Gemm g{OMEM, (const bf16_t*)(ws + WS_WOMEM), T, D, 512, 512, 512}; pg8::StaticOrder so; so.init(T, D, G, cu);
          pg8::EpiBf16 E{Y + (size_t)2 * T * D, D, D, 1.0f, true}; pg8::gemm_phase<pg8::EpiBf16, pg8::StaticOrder, true, true>(lds, g, so, E, wave); }
    }
    if (IN(9)) {
        PH_VARS;
        pg8::Gemm g{H, (const bf16_t*)(ws + WS_WGATE), T, 3072, D, D, D}; pg8::GateOrder so; so.init(T, G, cu);
        pg8::EpiGateMul E{Y, (size_t)T * D}; pg8::gemm_phase<pg8::EpiGateMul, pg8::GateOrder, true, true>(lds, g, so, E, wave);
    }
    SEAM(9);
    if (IN(10)) for (int rep_ = 0; rep_ < (PROBE_DUP == 20 ? 2 : 1); ++rep_) {
        PH_VARS;
        pg8::Gemm g{Y + (size_t)2 * T * D  , (const bf16_t*)(ws + WS_WOUT), T, D, D, D, D}; pg8::StaticOrder so; so.init(T, D, G, cu);
        pg8::EpiBf16 E{DL2, D, D, 1.0f, false}; pg8::gemm_phase<pg8::EpiBf16, pg8::StaticOrder, true, true>(lds, g, so, E, wave);
    }
    SEAM(10);
    if (IN(11)) for (int rep_ = 0; rep_ < (PROBE_DUP == 21 ? 2 : 1); ++rep_) { PH_VARS; for (int m = gw; m < T; m += 4 * NGW) resid_norm_row2<true, true, false>(X1B, DL2, X2B, ap->in[I_F2N], H, (size_t)m, (size_t)NGW, lane); }
    SEAM(11);
    if (IN(12)) for (int rep_ = 0; rep_ < (PROBE_DUP == 22 ? 2 : 1); ++rep_) {
        PH_VARS;
        pg8::Gemm g{H, (const bf16_t*)(ws + WS_WGU2), T, 2 * FF, D, D, D}; pg8::StaticOrder so; so.init(T, 2 * FF, G, cu);
        pg8::EpiSwiglu E{U, FF}; pg8::gemm_phase<pg8::EpiSwiglu, pg8::StaticOrder, true, true>(lds, g, so, E, wave);
    }
    SEAM(12);
    if (IN(13)) for (int rep_ = 0; rep_ < (PROBE_DUP == 23 ? 2 : 1); ++rep_) {
        PH_VARS;
        pg8::Gemm g{U, (const bf16_t*)(ws + WS_WD2), T, D, FF, FF, FF}; pg8::StaticOrder so; so.init(T, D, G, cu);
        pg8::EpiBf16 E{DL2, D, D, 0.5f, false}; pg8::gemm_phase<pg8::EpiBf16, pg8::StaticOrder, true, true>(lds, g, so, E, wave);
    }
    SEAM(13);
    if (IN(14)) { PH_VARS; for (int m = gw; m < T; m += 4 * NGW) resid_norm_row2<true, false, true>(X2B, DL2, nullptr, ap->in[I_FINN], out, (size_t)m, (size_t)NGW, lane); }
#undef IN
#undef SEAM
}
constexpr int N_PHASES = 15;

extern "C" void kernel_launch(void* const* d_in, const int* in_sizes, int n_in, void* d_out, int out_size, void* d_ws, size_t ws_size, hipStream_t stream) {
    static int grid = 0;
    if (grid == 0) {
        if (n_in != 24 || out_size != T * D || ws_size < WS_END) { fprintf(stderr, "kernel_launch: unexpected problem (n_in %d, out %d, ws %zu < %zu)\n", n_in, out_size, ws_size, (size_t)WS_END); grid = -1; return; }
        int dev = 0, cus = 0, per_cu = 0;
        if (hipGetDevice(&dev) != hipSuccess || hipDeviceGetAttribute(&cus, hipDeviceAttributeMultiprocessorCount, dev) != hipSuccess) { grid = -1; return; }
        if (hipFuncSetAttribute((const void*)mk_fwd, hipFuncAttributeMaxDynamicSharedMemorySize, LDS_BYTES) != hipSuccess) { fprintf(stderr, "kernel_launch: hipFuncSetAttribute failed\n"); grid = -1; return; }
        if (hipOccupancyMaxActiveBlocksPerMultiprocessor(&per_cu, (const void*)mk_fwd, NTHR, LDS_BYTES) != hipSuccess || per_cu < 1) { fprintf(stderr, "kernel_launch: occupancy query says %d\n", per_cu); per_cu = 1; }
        (void)hipGetLastError();
        grid = cus;
    }
    if (grid < 0) return;
    if (hipMemsetAsync((char*)d_ws + WS_CTL, 0, 16384, stream) != hipSuccess) { fprintf(stderr, "kernel_launch: memset failed\n"); return; }
    Args a{};
    for (int i = 0; i < 24; ++i) a.in[i] = (const float*)d_in[i];
    a.out = (float*)d_out; a.ws = (unsigned char*)d_ws;
#if MK_PER_PHASE
    for (int p = 0; p < N_PHASES; ++p) {
        a.ph_lo = p; a.ph_hi = p + 1; void* kargs[] = {&a};
        hipError_t e = hipLaunchCooperativeKernel((const void*)mk_fwd, dim3(grid), dim3(NTHR), kargs, LDS_BYTES, stream);
        if (e != hipSuccess) { fprintf(stderr, "kernel_launch: cooperative launch (phase %d) failed: %s\n", p, hipGetErrorString(e)); break; }
    }
#else
    a.ph_lo = 0; a.ph_hi = N_PHASES; void* kargs[] = {&a};
    hipError_t e = hipLaunchCooperativeKernel((const void*)mk_fwd, dim3(grid), dim3(NTHR), kargs, LDS_BYTES, stream);
    if (e != hipSuccess) fprintf(stderr, "kernel_launch: cooperative launch failed: %s (grid %d)\n", hipGetErrorString(e), grid);
#endif
}
```

```cpp
#include <hip/hip_runtime.h>
#include <hip/hip_cooperative_groups.h>
#include <cstdio>
#include <cstdint>
namespace cg = cooperative_groups;

#ifndef MK_PER_PHASE
#define MK_PER_PHASE 0
#endif

namespace pg8 {
#define PG8_LAS __attribute__((address_space(3)))
typedef unsigned short bf16_t;
typedef short bf16x8 __attribute__((ext_vector_type(8)));
typedef float f32x4 __attribute__((ext_vector_type(4)));
typedef unsigned u32x4 __attribute__((ext_vector_type(4)));
typedef unsigned u32x2 __attribute__((ext_vector_type(2)));
constexpr int BM = 256, BK = 64, HALF = 128, HTB = HALF * BK * 2  , STAGE_BYTES = 8 * HTB, NXCD = 8, WGM = 4;

__host__ __device__ __forceinline__ int lds_byte(int r, int c) { const int st = (r >> 4) * 2 + (c >> 5), rr = r & 15, cc = c & 31, ob = rr * 64 + cc * 2; return st * 1024 + (ob ^ (((ob >> 9) & 1) << 5)); }
__host__ __device__ __forceinline__ void stage_rc(int b, int& R, int& C) { const int st = b / 1024, sb = b % 1024, swz = sb ^ (((sb >> 9) & 1) << 5); R = (st >> 1) * 16 + swz / 64; C = (st & 1) * 32 + (swz % 64) / 2; }
__host__ __device__ __forceinline__ int perm32(int rho) { const int n = rho >> 4, i = rho & 15; return 8 * (i >> 2) + 4 * n + (i & 3); }

struct Unit { int pm, pn; };
struct Gemm { const bf16_t* A; const bf16_t* Bt; int M, N, K, lda, ldb; };

struct StaticOrder {
    int nM, nN, nwg, G, c;
    __host__ __device__ void init(int M, int N, int G_, int c_) { nM = M / BM; nN = N / BM; nwg = nM * nN; G = G_; c = c_; }
    __host__ __device__ bool next(int i, Unit& u) const {
        const long L = (long)i * G + c; if (L >= nwg) return false;
        int wgid = (int)L; { const int q = nwg / NXCD, r = nwg % NXCD, xcd = wgid % NXCD, off = wgid / NXCD; wgid = (xcd < r ? xcd * (q + 1) : r * (q + 1) + (xcd - r) * q) + off; }
        const int nig = WGM * nN, gid = wgid / nig, fm = gid * WGM, gsz = (nM - fm) < WGM ? (nM - fm) : WGM;
        u.pm = fm + ((wgid % nig) % gsz); u.pn = (wgid % nig) / gsz; return true;
    }
    __device__ __forceinline__ void a_ready(const Unit&) const {}
    __device__ __forceinline__ void done(const Unit&) const {}
};
struct GateOrder {
    StaticOrder so;
    __host__ __device__ void init(int M, int G_, int c_) { so.init(M, 1024, G_, c_); }
    __host__ __device__ bool next(int i, Unit& u) const {
        const int rnd = i / 3, b = 2 - i % 3; Unit t;
        if (!so.next(rnd, t)) return false;
        u.pm = t.pm; u.pn = b * 4 + t.pn; return true;
    }
    __device__ __forceinline__ void a_ready(const Unit&) const {}
    __device__ __forceinline__ void done(const Unit&) const {}
};

__device__ __forceinline__ int fresh_lane() { unsigned m = ~0u; asm volatile("" : "+s"(m)); return (int)__builtin_amdgcn_mbcnt_hi(m, __builtin_amdgcn_mbcnt_lo(m, 0u)); }
__device__ __forceinline__ unsigned cvt_pk_bf16(float lo, float hi) { unsigned r; asm volatile("v_cvt_pk_bf16_f32 %0, %1, %2" : "=v"(r) : "v"(lo), "v"(hi)); return r; }
__device__ __forceinline__ float bf_lo(unsigned w) { return __builtin_bit_cast(float, w << 16); }
__device__ __forceinline__ float bf_hi(unsigned w) { return __builtin_bit_cast(float, w & 0xffff0000u); }
__device__ __forceinline__ float sigmoidf_(float v) { return __builtin_amdgcn_rcpf(1.0f + __builtin_amdgcn_exp2f(-1.4426950408889634f * v)); }


struct EpiBf16 {
    static constexpr bool PERM = true, AFTER_DRAIN = false;
    bf16_t* O; int ldc; int ncols; float scale; bool keep;
    __device__ __forceinline__ void operator()(const f32x4 (&acc)[2][2][4][2], const Unit& u, int wr, int wc, int fr_, int fq_) const {
        int fr = fr_, fq = fq_; asm volatile("" : "+v"(fr), "+v"(fq));
        const int row0 = u.pm * BM + wr * 64 + fr; const int col0 = u.pn * BM + wc * 32 + 8 * fq;
#pragma unroll
        for (int ai = 0; ai < 2; ++ai)
#pragma unroll
            for (int m = 0; m < 4; ++m) { bf16_t* rowp = O + (size_t)(row0 + ai * HALF + m * 16) * ldc + col0;
#pragma unroll
                for (int bj = 0; bj < 2; ++bj) { const f32x4 v0 = acc[ai][bj][m][0] * scale, v1 = acc[ai][bj][m][1] * scale;
                    u32x4 w; w.x = cvt_pk_bf16(v0[0], v0[1]); w.y = cvt_pk_bf16(v0[2], v0[3]); w.z = cvt_pk_bf16(v1[0], v1[1]); w.w = cvt_pk_bf16(v1[2], v1[3]);
                    if (col0 + bj * HALF < ncols) { if (keep) *(u32x4*)(rowp + bj * HALF) = w; else __builtin_nontemporal_store(w, (u32x4*)(rowp + bj * HALF)); } } }
    }
};
struct EpiSwiglu {
    static constexpr bool PERM = true, AFTER_DRAIN = false;
    bf16_t* O; int ldc;
    __device__ __forceinline__ void operator()(const f32x4 (&acc)[2][2][4][2], const Unit& u, int wr, int wc, int fr_, int fq_) const {
        int fr = fr_, fq = fq_; asm volatile("" : "+v"(fr), "+v"(fq));
        const int row0 = u.pm * BM + wr * 64 + fr; const int col0 = u.pn * HALF + wc * 32 + 8 * fq;
#pragma unroll
        for (int ai = 0; ai < 2; ++ai)
#pragma unroll
            for (int m = 0; m < 4; ++m) { bf16_t* rowp = O + (size_t)(row0 + ai * HALF + m * 16) * ldc + col0;
                float v[8];
#pragma unroll
                for (int n = 0; n < 2; ++n)
#pragma unroll
                    for (int j = 0; j < 4; ++j) { const float g = acc[ai][0][m][n][j], up = acc[ai][1][m][n][j]; v[4 * n + j] = g * sigmoidf_(g) * up; }
                u32x4 w; w.x = cvt_pk_bf16(v[0], v[1]); w.y = cvt_pk_bf16(v[2], v[3]); w.z = cvt_pk_bf16(v[4], v[5]); w.w = cvt_pk_bf16(v[6], v[7]);
                __builtin_nontemporal_store(w, (u32x4*)rowp); }
    }
};
struct EpiResid {
    static constexpr bool PERM = false, AFTER_DRAIN = false;
    const float* base; float* out; int ldc; float scale;
    __device__ __forceinline__ void operator()(const f32x4 (&acc)[2][2][4][2], const Unit& u, int wr, int wc, int fr_, int fq_) const {
        int fr = fr_, fq = fq_; asm volatile("" : "+v"(fr), "+v"(fq));
        const int row0 = u.pm * BM + wr * 64 + fr; const int col0 = u.pn * BM + wc * 32 + 4 * fq;
#pragma unroll
        for (int ai = 0; ai < 2; ++ai)
#pragma unroll
            for (int m = 0; m < 4; ++m) { const size_t off = (size_t)(row0 + ai * HALF + m * 16) * ldc + col0;
#pragma unroll
                for (int bj = 0; bj < 2; ++bj)
#pragma unroll
                    for (int n = 0; n < 2; ++n) { const f32x4 b = *(const f32x4*)(base + off + bj * HALF + n * 16); *(f32x4*)(out + off + bj * HALF + n * 16) = b + acc[ai][bj][m][n] * scale; } }
    }
};
struct EpiQRope {
    static constexpr bool PERM = false, AFTER_DRAIN = false;
    bf16_t* O; int ldc; const float* tab; float qscale;
    __device__ __forceinline__ void operator()(const f32x4 (&acc)[2][2][4][2], const Unit& u, int wr, int wc, int fr_, int fq_) const {
        int fr = fr_, fq = fq_; asm volatile("" : "+v"(fr), "+v"(fq));
        const int row0 = u.pm * BM + wr * 64 + fr;
#pragma unroll
        for (int bj = 0; bj < 2; ++bj) { const int grp = u.pn * 8 + bj * 4 + wc; const bool rot = (grp % 3) == 2; const int col = grp * 32 + 4 * fq;
#pragma unroll
            for (int ai = 0; ai < 2; ++ai)
#pragma unroll
                for (int m = 0; m < 4; ++m) { const int row = row0 + ai * HALF + m * 16; f32x4 v0 = acc[ai][bj][m][0], v1 = acc[ai][bj][m][1];
                    if (rot) { const f32x4 t0 = *(const f32x4*)(tab + (size_t)row * 32 + 8 * fq), t1 = *(const f32x4*)(tab + (size_t)row * 32 + 8 * fq + 4);
                        const float c[4] = {t0[0], t0[2], t1[0], t1[2]}, s[4] = {t0[1], t0[3], t1[1], t1[3]};
#pragma unroll
                        for (int j = 0; j < 4; ++j) { const float x1 = v0[j], x2 = v1[j]; v0[j] = x1 * c[j] - x2 * s[j]; v1[j] = x2 * c[j] + x1 * s[j]; } }
                    v0 = v0 * qscale; v1 = v1 * qscale;
                    u32x2 w0, w1; w0.x = cvt_pk_bf16(v0[0], v0[1]); w0.y = cvt_pk_bf16(v0[2], v0[3]); w1.x = cvt_pk_bf16(v1[0], v1[1]); w1.y = cvt_pk_bf16(v1[2], v1[3]);
                    bf16_t* p = O + (size_t)row * ldc + col; *(u32x2*)p = w0; *(u32x2*)(p + 16) = w1; } }
    }
};
struct EpiGateMul {
    static constexpr bool PERM = true, AFTER_DRAIN = false;
    bf16_t* Y0; size_t ystride;
    __device__ __forceinline__ void operator()(const f32x4 (&acc)[2][2][4][2], const Unit& u, int wr, int wc, int fr_, int fq_) const {
        int fr = fr_, fq = fq_; asm volatile("" : "+v"(fr), "+v"(fq));
        const int b = u.pn >> 2, jn = u.pn & 3; const int row0 = u.pm * BM + wr * 64 + fr; const int col0 = jn * BM + wc * 32 + 8 * fq;
        const bf16_t* Yb = Y0 + (size_t)b * ystride; bf16_t* Ya = Y0 + (size_t)2 * ystride; const bool rmw = (b != 2);
#pragma unroll
        for (int ai = 0; ai < 2; ++ai) {
            u32x4 yv[4][2], pv[4][2];
#pragma unroll
            for (int m = 0; m < 4; ++m)
#pragma unroll
                for (int bj = 0; bj < 2; ++bj) { const size_t off = (size_t)(row0 + ai * HALF + m * 16) * 1024 + col0 + bj * HALF; yv[m][bj] = *(const u32x4*)(Yb + off); if (rmw) pv[m][bj] = *(const u32x4*)(Ya + off); }
#pragma unroll
            for (int m = 0; m < 4; ++m)
#pragma unroll
                for (int bj = 0; bj < 2; ++bj) { const size_t off = (size_t)(row0 + ai * HALF + m * 16) * 1024 + col0 + bj * HALF; const u32x4 y = yv[m][bj]; const f32x4 a0 = acc[ai][bj][m][0], a1 = acc[ai][bj][m][1];
                    float v[8];
                    v[0] = sigmoidf_(a0[0]) * bf_lo(y.x); v[1] = sigmoidf_(a0[1]) * bf_hi(y.x); v[2] = sigmoidf_(a0[2]) * bf_lo(y.y); v[3] = sigmoidf_(a0[3]) * bf_hi(y.y);
                    v[4] = sigmoidf_(a1[0]) * bf_lo(y.z); v[5] = sigmoidf_(a1[1]) * bf_hi(y.z); v[6] = sigmoidf_(a1[2]) * bf_lo(y.w); v[7] = sigmoidf_(a1[3]) * bf_hi(y.w);
                    if (rmw) { const u32x4 p = pv[m][bj];
                        v[0] += bf_lo(p.x); v[1] += bf_hi(p.x); v[2] += bf_lo(p.y); v[3] += bf_hi(p.y); v[4] += bf_lo(p.z); v[5] += bf_hi(p.z); v[6] += bf_lo(p.w); v[7] += bf_hi(p.w); }
                    u32x4 w; w.x = cvt_pk_bf16(v[0], v[1]); w.y = cvt_pk_bf16(v[2], v[3]); w.z = cvt_pk_bf16(v[4], v[5]); w.w = cvt_pk_bf16(v[6], v[7]);
                    if (b == 0) __builtin_nontemporal_store(w, (u32x4*)(Ya + off)); else *(u32x4*)(Ya + off) = w; }
        }
    }
};

template <class Epi, class Sched, bool ALIGN_EPI = false, bool SP2 = false>
__device__ __forceinline__ void gemm_phase(PG8_LAS unsigned char* lds, const Gemm g, const Sched& S, const Epi& E, const int wid_in) {
    const int lane = fresh_lane(), wid = wid_in, tid = wid * 64 + lane, wr = wid >> 2, wc = wid & 3, fr = lane & 15, fq = lane >> 4;
    const int K = g.K, nt = K / BK;
    unsigned voffA[2], voffB[2];
#pragma unroll
    for (int i = 0; i < 2; ++i) { int R, C; stage_rc(tid * 16 + i * 8192, R, C); const int Rb = Epi::PERM ? ((R & ~31) + perm32(R & 31)) : R;
        voffA[i] = (unsigned)(R * g.lda + C) * 2u; voffB[i] = (unsigned)(Rb * g.ldb + C) * 2u; }
    const size_t kstep = (size_t)(BK * 2);
    const size_t hstepA = (size_t)HALF * g.lda * 2, hstepB = (size_t)HALF * g.ldb * 2;
    const size_t tstepA = 2 * hstepA, tstepB = 2 * hstepB;
    const unsigned ldsw = (unsigned)wid * 1024u;
    const int aoff = lds_byte(wr * 64 + fr, fq * 8), boff = lds_byte(wc * 32 + fr, fq * 8);
#define PG8_SA(b, h) (((b) * 2 + (h)) * HTB)
#define PG8_SB(b, h) ((4 + (b) * 2 + (h)) * HTB)
#define PG8_STAGE(bufoff, gbase, voff) do { _Pragma("unroll") for (int _i = 0; _i < 2; ++_i) \
        __builtin_amdgcn_global_load_lds((const unsigned*)((const char*)(gbase) + (voff)[_i]), (PG8_LAS unsigned*)(lds + (bufoff) + ldsw + _i * 8192), 16, 0, 0); } while (0)
#define PG8_LDA(dst, b, h) do { _Pragma("unroll") for (int m = 0; m < 4; ++m) _Pragma("unroll") for (int k = 0; k < 2; ++k) dst[m][k] = *(const PG8_LAS bf16x8*)(lds + PG8_SA(b, h) + aoff + m * 2048 + k * 1024); } while (0)
#define PG8_LDB(dst, b, h) do { _Pragma("unroll") for (int n = 0; n < 2; ++n) _Pragma("unroll") for (int k = 0; k < 2; ++k) dst[n][k] = *(const PG8_LAS bf16x8*)(lds + PG8_SB(b, h) + boff + n * 2048 + k * 1024); } while (0)
#define PG8_MMA(ai, bj, At, Bt) do { __builtin_amdgcn_s_setprio(1); _Pragma("unroll") for (int m = 0; m < 4; ++m) _Pragma("unroll") for (int n = 0; n < 2; ++n) _Pragma("unroll") for (int k = 0; k < 2; ++k) \
        acc[ai][bj][m][n] = __builtin_amdgcn_mfma_f32_16x16x32_bf16(Bt[n][k], At[m][k], acc[ai][bj][m][n], 0, 0, 0); __builtin_amdgcn_s_setprio(0); } while (0)
#define PG8_WAIT_V(n) asm volatile("s_waitcnt vmcnt(" #n ")" ::: "memory")
#define PG8_WAIT_L(n) asm volatile("s_waitcnt lgkmcnt(" #n ")" ::: "memory")
#define PG8_BAR __builtin_amdgcn_s_barrier()
#define PG8_SCHED __builtin_amdgcn_sched_barrier(0)
    Unit cur, nxt; int ui = 0;
    if (!S.next(0, cur)) return;
    f32x4 acc[2][2][4][2];
#pragma unroll
    for (int a = 0; a < 2; ++a)
#pragma unroll
        for (int b = 0; b < 2; ++b)
#pragma unroll
            for (int m = 0; m < 4; ++m)
#pragma unroll
                for (int n = 0; n < 2; ++n) acc[a][b][m][n] = (f32x4){0.f, 0.f, 0.f, 0.f};
    bf16x8 At[4][2], B0[2][2], B1[2][2];
    const char* cA = (const char*)g.A + (size_t)cur.pm * tstepA; const char* cB = (const char*)g.Bt + (size_t)cur.pn * tstepB;
    S.a_ready(cur);
    if constexpr (SP2) {
        PG8_STAGE(PG8_SB(0, 0), cB, voffB); PG8_STAGE(PG8_SB(0, 1), cB + hstepB, voffB); PG8_STAGE(PG8_SA(0, 0), cA, voffA); PG8_STAGE(PG8_SA(0, 1), cA + hstepA, voffA);
        if (wr == 1) PG8_BAR;
        PG8_WAIT_V(2); PG8_BAR;
        PG8_STAGE(PG8_SB(1, 0), cB + kstep, voffB); PG8_STAGE(PG8_SA(1, 0), cA + kstep, voffA); PG8_STAGE(PG8_SB(1, 1), cB + hstepB + kstep, voffB);
        PG8_WAIT_V(6); PG8_BAR;
    } else {
        PG8_STAGE(PG8_SB(0, 0), cB, voffB); PG8_STAGE(PG8_SA(0, 0), cA, voffA); PG8_STAGE(PG8_SB(0, 1), cB + hstepB, voffB); PG8_STAGE(PG8_SA(0, 1), cA + hstepA, voffA);
        if (wr == 1) PG8_BAR;
        PG8_WAIT_V(4); PG8_BAR;
        PG8_STAGE(PG8_SB(1, 0), cB + kstep, voffB); PG8_STAGE(PG8_SA(1, 0), cA + kstep, voffA); PG8_STAGE(PG8_SB(1, 1), cB + hstepB + kstep, voffB);
        PG8_WAIT_V(6); PG8_BAR;
    }
    for (;;) {
        const bool has_next = S.next(ui + 1, nxt);
        const char* nA = has_next ? (const char*)g.A + (size_t)nxt.pm * tstepA : cA; const char* nB = has_next ? (const char*)g.Bt + (size_t)nxt.pn * tstepB : cB;
#pragma nounroll
        for (int t = 0; t < nt; t += 2) {
            const bool last = (t == nt - 2);
            const char* a1 = cA + (size_t)(t + 1) * kstep;
            const char* a2 = last ? nA : cA + (size_t)(t + 2) * kstep; const char* b2 = last ? nB : cB + (size_t)(t + 2) * kstep;
            const char* a3 = a2 + kstep; const char* b3 = b2 + kstep;
            if (last && has_next) S.a_ready(nxt);
            if constexpr (SP2) {
            PG8_LDB(B0, 0, 0); PG8_LDB(B1, 0, 1); PG8_SCHED; PG8_LDA(At, 0, 0); PG8_STAGE(PG8_SA(1, 1), a1 + hstepA, voffA);
            PG8_WAIT_V(8); PG8_WAIT_L(0); PG8_BAR; PG8_MMA(0, 0, At, B0); PG8_MMA(0, 1, At, B1); PG8_BAR; PG8_SCHED;
            PG8_LDA(At, 0, 1); PG8_STAGE(PG8_SB(0, 0), b2, voffB); PG8_STAGE(PG8_SB(0, 1), b2 + hstepB, voffB); PG8_STAGE(PG8_SA(0, 0), a2, voffA);
            PG8_WAIT_V(8); PG8_WAIT_L(0); PG8_BAR; PG8_MMA(1, 0, At, B0); PG8_MMA(1, 1, At, B1); PG8_BAR; PG8_SCHED;
            PG8_LDB(B0, 1, 0); PG8_LDB(B1, 1, 1); PG8_SCHED; PG8_LDA(At, 1, 0); PG8_STAGE(PG8_SA(0, 1), a2 + hstepA, voffA);
            PG8_WAIT_V(8); PG8_WAIT_L(0); PG8_BAR; PG8_MMA(0, 0, At, B0); PG8_MMA(0, 1, At, B1); PG8_BAR; PG8_SCHED;
            PG8_LDA(At, 1, 1); PG8_STAGE(PG8_SB(1, 0), b3, voffB); PG8_STAGE(PG8_SB(1, 1), b3 + hstepB, voffB); PG8_STAGE(PG8_SA(1, 0), a3, voffA);
            PG8_WAIT_V(8); PG8_WAIT_L(0); PG8_BAR; PG8_MMA(1, 0, At, B0); PG8_MMA(1, 1, At, B1); PG8_BAR; PG8_SCHED;
            } else {
            PG8_LDB(B0, 0, 0); PG8_SCHED; PG8_LDA(At, 0, 0); PG8_STAGE(PG8_SA(1, 1), a1 + hstepA, voffA);
            PG8_WAIT_L(8); PG8_BAR; PG8_WAIT_L(0); PG8_MMA(0, 0, At, B0); PG8_BAR; PG8_SCHED;
            PG8_LDB(B1, 0, 1); PG8_STAGE(PG8_SB(0, 0), b2, voffB);
            PG8_BAR; PG8_WAIT_L(0); PG8_MMA(0, 1, At, B1); PG8_BAR;
            PG8_LDA(At, 0, 1); PG8_STAGE(PG8_SA(0, 0), a2, voffA);
            PG8_BAR; PG8_WAIT_L(0); PG8_MMA(1, 0, At, B0); PG8_BAR; PG8_SCHED;
            PG8_STAGE(PG8_SB(0, 1), b2 + hstepB, voffB);
            PG8_WAIT_V(6); PG8_BAR; PG8_MMA(1, 1, At, B1); PG8_BAR;
            PG8_LDB(B0, 1, 0); PG8_SCHED; PG8_LDA(At, 1, 0); PG8_STAGE(PG8_SA(0, 1), a2 + hstepA, voffA);
            PG8_WAIT_L(8); PG8_BAR; PG8_WAIT_L(0); PG8_MMA(0, 0, At, B0); PG8_BAR; PG8_SCHED;
            PG8_LDB(B1, 1, 1); PG8_STAGE(PG8_SB(1, 0), b3, voffB);
            PG8_BAR; PG8_WAIT_L(0); PG8_MMA(0, 1, At, B1); PG8_BAR;
            PG8_LDA(At, 1, 1); PG8_STAGE(PG8_SA(1, 0), a3, voffA);
            PG8_BAR; PG8_WAIT_L(0); PG8_MMA(1, 0, At, B0); PG8_BAR; PG8_SCHED;
            PG8_STAGE(PG8_SB(1, 1), b3 + hstepB, voffB);
            PG8_WAIT_V(6); PG8_BAR; PG8_MMA(1, 1, At, B1); PG8_BAR;
            }
        }
        if constexpr (ALIGN_EPI) { if (wr == 0) PG8_BAR; }
        if constexpr (!Epi::AFTER_DRAIN) { E(acc, cur, wr, wc, fr, fq); S.done(cur); }
        if (!has_next) break;
#pragma unroll
        for (int a = 0; a < 2; ++a)
#pragma unroll
            for (int b = 0; b < 2; ++b)
#pragma unroll
                for (int m = 0; m < 4; ++m)
#pragma unroll
                    for (int n = 0; n < 2; ++n) acc[a][b][m][n] = (f32x4){0.f, 0.f, 0.f, 0.f};
        cur = nxt; cA = nA; cB = nB; ++ui;
        if constexpr (ALIGN_EPI) { if (wr == 1) PG8_BAR; }
    }
    PG8_WAIT_V(0);
    if constexpr (!ALIGN_EPI) { if (wr == 0) PG8_BAR; }
    PG8_BAR;
    if constexpr (Epi::AFTER_DRAIN) { E.fused(acc, cur, wr, wc, fr, fq, lds, wid, lane); S.done(cur); }
#undef PG8_SA
#undef PG8_SB
#undef PG8_STAGE
#undef PG8_LDA
#undef PG8_LDB
#undef PG8_MMA
#undef PG8_WAIT_V
#undef PG8_WAIT_L
#undef PG8_BAR
#undef PG8_SCHED
}
}

using pg8::bf16_t; using pg8::bf16x8; using pg8::f32x4; using pg8::u32x4; using pg8::u32x2; using pg8::cvt_pk_bf16; using pg8::bf_lo; using pg8::bf_hi;
typedef float f32x16 __attribute__((ext_vector_type(16)));
#define LAS __attribute__((address_space(3)))

constexpr int NB = 8, S = 4096, T = NB * S, D = 1024, FF = 2816, NMEM = 256;
constexpr int LDZ = 3360, NZP = 3584;
constexpr int ZQ = 0, ZKV = 384, ZKR = 512, ZDQ = 544, ZDK = 1312, ZDV = 2080, ZMQ = 2848;
constexpr float EPS = 1e-6f;
constexpr float LOG2E = 1.4426950408889634f;
constexpr int NWAVES = 8, NTHR = 512;

constexpr size_t MiB = 1u << 20;
constexpr size_t SZ_WGU = (size_t)2 * FF * D * 2, SZ_WD = (size_t)D * FF * 2;
constexpr size_t WS_WGU1 = 0, WS_WD1 = WS_WGU1 + SZ_WGU, WS_WGU2 = WS_WD1 + SZ_WD, WS_WD2 = WS_WGU2 + SZ_WGU;
constexpr size_t WS_WIN = WS_WD2 + SZ_WD, WS_WGATE = WS_WIN + (size_t)NZP * D * 2, WS_WUQ = WS_WGATE + (size_t)3072 * D * 2;
constexpr size_t WS_WUKV = WS_WUQ + (size_t)768 * 384 * 2, WS_WOMLA = WS_WUKV + (size_t)1024 * 128 * 2, WS_WODIL = WS_WOMLA + (size_t)1024 * 768 * 2;
constexpr size_t WS_WMEMKV = WS_WODIL + (size_t)1024 * 256 * 2, WS_WOMEM = WS_WMEMKV + (size_t)1024 * 1024 * 2, WS_WOUT = WS_WOMEM + (size_t)1024 * 512 * 2;
constexpr size_t WS_WEND = WS_WOUT + (size_t)1024 * 1024 * 2;
static_assert(WS_WEND <= 54 * MiB, "weights");
constexpr size_t WS_TABM = 54 * MiB;
constexpr size_t WS_TABD = 58 * MiB;
constexpr size_t WS_LSE = 60 * MiB;
constexpr size_t WS_CTL = 61 * MiB + 768 * 1024;
constexpr size_t WS_MEMKV = 62 * MiB;
constexpr size_t WS_H = 66 * MiB;
constexpr size_t WS_R1 = 130 * MiB;
constexpr size_t WS_QM = 340 * MiB;
constexpr size_t WS_KV = 388 * MiB;
constexpr size_t WS_ODIL = 452 * MiB;
constexpr size_t WS_OMEM = 468 * MiB;
constexpr size_t WS_END = 500 * MiB;
static_assert(WS_R1 + (size_t)T * LDZ * 2 <= WS_QM && WS_R1 + (size_t)T * FF * 2 <= WS_QM && WS_R1 + (size_t)3 * T * D * 2 <= WS_QM, "R1");
static_assert(WS_QM + 128 * MiB <= WS_OMEM, "delta2/3 and x2 (bf16) overlay q | k | v | o_dil");
static_assert(WS_TABM + (size_t)T * 128 <= WS_TABD && WS_TABD + (size_t)T * 64 <= WS_LSE && WS_LSE + (size_t)3 * T * 16 <= WS_CTL && WS_CTL + 16384 <= WS_MEMKV, "tables");

#ifndef PROBE_DBG
#define PROBE_DBG 0
#endif
#ifndef PROBE_DUP
#define PROBE_DUP 0
#endif
constexpr int LDS_BYTES = 147456;

__device__ const float INV_FREQ[16] = {1.000000000e+00f, 4.403665960e-01f, 1.939227432e-01f, 8.539710194e-02f, 3.760603070e-02f, 1.656043902e-02f, 7.292664610e-03f, 3.211445874e-03f,
                                       1.414213562e-03f, 6.227723788e-04f, 2.742481884e-04f, 1.207697351e-04f, 5.318296098e-05f, 2.341999971e-05f, 1.031338616e-05f, 4.541670478e-06f};

struct Args { const float* in[24]; float* out; unsigned char* ws; int ph_lo, ph_hi; };
enum { I_X = 0, I_MEM, I_POS, I_F1N, I_F1G, I_F1U, I_F1D, I_MIXN, I_WIN, I_QN, I_WUQ, I_KVN, I_WUKV, I_WOMLA, I_WODIL, I_MEMN, I_WMEMKV, I_WOMEM, I_WOUT, I_F2N, I_F2G, I_F2U, I_F2D, I_FINN };

__device__ __forceinline__ float wave_sum(float v) {
#pragma unroll
    for (int o = 1; o < 64; o <<= 1) v += __shfl_xor(v, o);
    return v;
}
__device__ __forceinline__ unsigned f2bf(float f) { unsigned u = __builtin_bit_cast(unsigned, f); return (u + 0x7fffu + ((u >> 16) & 1u)) >> 16; }
__device__ __forceinline__ float bf2f(unsigned short h) { return __builtin_bit_cast(float, (unsigned)h << 16); }
__device__ __forceinline__ void sincos_acc(float angf, float& c, float& s) {
    const double a = (double)angf;
    const double k = __builtin_rint(a * 0.63661977236758134308);
    double r = __builtin_fma(-k, 1.57079632679489655800, a); r = __builtin_fma(-k, 6.12323399573676603587e-17, r);
    const int q = (int)((long long)k & 3);
    const double r2 = r * r;
    const double sp = r * (1.0 + r2 * (-1.0 / 6 + r2 * (1.0 / 120 + r2 * (-1.0 / 5040 + r2 * (1.0 / 362880 + r2 * (-1.0 / 39916800))))));
    const double cp = 1.0 + r2 * (-0.5 + r2 * (1.0 / 24 + r2 * (-1.0 / 720 + r2 * (1.0 / 40320 + r2 * (-1.0 / 3628800 + r2 * (1.0 / 479001600))))));
    const double ss = (q & 1) ? cp : sp, cc = (q & 1) ? sp : cp;
    s = (float)((q & 2) ? -ss : ss); c = (float)(((q + 1) & 2) ? -cc : cc);
}

__device__ __forceinline__ void transpose_item(const float* W, int ldw, int col, bf16_t* WT, int ldt, int drow0, int dk0, int k0, LAS float* scr, int lane, bool zgap) {
#pragma unroll 8
    for (int i = 0; i < 32; ++i) { const int kk = 2 * i + (lane >> 5); scr[kk * 33 + (lane & 31)] = W[(size_t)(k0 + kk) * ldw + col + (lane & 31)]; }
    asm volatile("s_waitcnt lgkmcnt(0)" ::: "memory");
    const int c = lane & 7;
#pragma unroll
    for (int j = 0; j < 4; ++j) { const int n = (lane >> 3) + 8 * j; const LAS float* s = scr + (8 * c) * 33 + n;
        u32x4 o; o.x = cvt_pk_bf16(s[0 * 33], s[1 * 33]); o.y = cvt_pk_bf16(s[2 * 33], s[3 * 33]); o.z = cvt_pk_bf16(s[4 * 33], s[5 * 33]); o.w = cvt_pk_bf16(s[6 * 33], s[7 * 33]);
        *(u32x4*)(WT + (size_t)(drow0 + n) * ldt + dk0 + 8 * c) = o; }
    if (zgap) {
#pragma unroll
        for (int j = 0; j < 2; ++j) { const int e = lane + 64 * j, n = e >> 2, ch = e & 3; *(u32x4*)(WT + (size_t)(drow0 + n) * ldt + dk0 + 64 + 8 * ch) = (u32x4){0u, 0u, 0u, 0u}; }
    }
    asm volatile("s_waitcnt lgkmcnt(0)" ::: "memory");
}
struct WD { const float* src; bf16_t* dst; int ldw, col0, ncols, K, ldt, mode; };
constexpr int N_WD = 17;
__device__ __forceinline__ WD wt_desc(int d, __attribute__((address_space(4))) const Args* ap) {
    unsigned char* ws = ap->ws;
    switch (d) {
    case 0: return WD{ap->in[I_F1G], (bf16_t*)(ws + WS_WGU1), FF, 0, FF, D, D, 1};
    case 1: return WD{ap->in[I_F1U], (bf16_t*)(ws + WS_WGU1), FF, 0, FF, D, D, 2};
    case 2: return WD{ap->in[I_F1D], (bf16_t*)(ws + WS_WD1), D, 0, D, FF, FF, 0};
    case 3: return WD{ap->in[I_F2G], (bf16_t*)(ws + WS_WGU2), FF, 0, FF, D, D, 1};
    case 4: return WD{ap->in[I_F2U], (bf16_t*)(ws + WS_WGU2), FF, 0, FF, D, D, 2};
    case 5: return WD{ap->in[I_F2D], (bf16_t*)(ws + WS_WD2), D, 0, D, FF, FF, 0};
    case 6: return WD{ap->in[I_WIN], (bf16_t*)(ws + WS_WIN), 6432, 0, LDZ, D, D, 0};
    case 7: return WD{ap->in[I_WIN], (bf16_t*)(ws + WS_WGATE), 6432, LDZ, 3072, D, D, 0};
    case 8: return WD{ap->in[I_WUQ], (bf16_t*)(ws + WS_WUQ), 768, 0, 768, 384, 384, 0};
    case 9: return WD{ap->in[I_WUKV], (bf16_t*)(ws + WS_WUKV), 1024, 0, 1024, 128, 128, 4};
    case 10: return WD{ap->in[I_WOMLA], (bf16_t*)(ws + WS_WOMLA), 1024, 0, 1024, 512, 512, 0};
    case 11: return WD{ap->in[I_WODIL], (bf16_t*)(ws + WS_WODIL), 1024, 0, 1024, 256, 256, 0};
    case 12: return WD{ap->in[I_WMEMKV], (bf16_t*)(ws + WS_WMEMKV), 1024, 0, 1024, 1024, 1024, 0};
    case 13: return WD{ap->in[I_WOMEM], (bf16_t*)(ws + WS_WOMEM), 1024, 0, 1024, 512, 512, 0};
    case 14: return WD{ap->in[I_WOUT], (bf16_t*)(ws + WS_WOUT), 1024, 0, 1024, 1024, 1024, 0};
    default: return WD{nullptr, nullptr, 0, 0, 0, 0, 0, 0};
    }
}
__device__ __forceinline__ int wt_items(int d) {
    switch (d) {
    case 0: case 1: case 3: case 4: return (D / 64) * (FF / 32);
    case 2: case 5: return (FF / 64) * (D / 32);
    case 6: return (D / 64) * (LDZ / 32);
    case 7: return (D / 64) * (3072 / 32);
    case 8: return (384 / 64) * (768 / 32);
    case 9: return (128 / 64) * (1024 / 32);
    case 10: return (512 / 64) * (1024 / 32);
    case 11: return (256 / 64) * (1024 / 32);
    case 12: return (1024 / 64) * (1024 / 32);
    case 13: return (512 / 64) * (1024 / 32);
    case 14: return (1024 / 64) * (1024 / 32);
    default: return 0;
    }
}
__device__ __forceinline__ bool wt_early(int d) { return d == 0 || d == 1 || d == 12; }
constexpr int WT_EARLY = 2 * (D / 64) * (FF / 32) + (1024 / 64) * (1024 / 32);
constexpr int WT_TOTAL = 4 * (D / 64) * (FF / 32) + 2 * (FF / 64) * (D / 32) + (D / 64) * (LDZ / 32) + (D / 64) * (3072 / 32) + (384 / 64) * (768 / 32) + (128 / 64) * (1024 / 32)
                         + (512 / 64) * (1024 / 32) + (256 / 64) * (1024 / 32) + (1024 / 64) * (1024 / 32) + (512 / 64) * (1024 / 32) + (1024 / 64) * (1024 / 32);
struct WItem { const float* srcp; bf16_t* dstp; int ldw, ldt; bool zgap; };
template <bool EARLY>
__device__ __forceinline__ void wt_decode(int it, __attribute__((address_space(4))) const Args* ap, WItem& I) {
    int r = it, d = 0;
    for (; d < N_WD; ++d) { if (wt_early(d) != EARLY) continue; const int n = wt_items(d); if (r < n) break; r -= n; }
    const WD w = wt_desc(d, ap);
    const int nblk = w.ncols / 32, kb = r / nblk, nb = r % nblk, k0 = 64 * kb, n0 = 32 * nb;
    int drow0 = n0; if (w.mode == 1) drow0 = (n0 >> 7) * 256 + (n0 & 127); else if (w.mode == 2) drow0 = (n0 >> 7) * 256 + 128 + (n0 & 127); else if (w.mode == 4) drow0 = (n0 >> 7) * 64 + (n0 & 63) + ((n0 & 64) ? 512 : 0);
    const int dk0 = (w.mode == 3) ? kb * 96 : k0;
    I.srcp = w.src + (size_t)k0 * w.ldw + w.col0 + n0; I.dstp = w.dst + (size_t)drow0 * w.ldt + dk0; I.ldw = w.ldw; I.ldt = w.ldt; I.zgap = (w.mode == 3);
}
__device__ __forceinline__ void wt_load32(const WItem& I, float (&f)[32], int lane) {
#pragma unroll
    for (int i = 0; i < 32; ++i) f[i] = I.srcp[(size_t)(2 * i + (lane >> 5)) * I.ldw + (lane & 31)];
}
__device__ __forceinline__ void wt_finish(const WItem& I, const float (&f)[32], LAS float* scr, int lane) {
#pragma unroll
    for (int i = 0; i < 32; ++i) scr[(2 * i + (lane >> 5)) * 33 + (lane & 31)] = f[i];
    asm volatile("s_waitcnt lgkmcnt(0)" ::: "memory");
    const int c = lane & 7;
#pragma unroll
    for (int j = 0; j < 4; ++j) { const int n = (lane >> 3) + 8 * j; const LAS float* s = scr + (8 * c) * 33 + n;
        u32x4 o; o.x = cvt_pk_bf16(s[0 * 33], s[1 * 33]); o.y = cvt_pk_bf16(s[2 * 33], s[3 * 33]); o.z = cvt_pk_bf16(s[4 * 33], s[5 * 33]); o.w = cvt_pk_bf16(s[6 * 33], s[7 * 33]);
        *(u32x4*)(I.dstp + (size_t)n * I.ldt + 8 * c) = o; }
    if (I.zgap) {
#pragma unroll
        for (int j = 0; j < 2; ++j) { const int e = lane + 64 * j, n = e >> 2, ch = e & 3; *(u32x4*)(I.dstp + (size_t)n * I.ldt + 64 + 8 * ch) = (u32x4){0u, 0u, 0u, 0u}; }
    }
    asm volatile("s_waitcnt lgkmcnt(0)" ::: "memory");
}
template <bool EARLY>
__device__ __forceinline__ void wt_run(__attribute__((address_space(4))) const Args* ap, LAS float* scr, int lane, int first, int stride, int total) {
    int it = first; if (it >= total) return;
    WItem A, B; float f[32], g[32];
    wt_decode<EARLY>(it, ap, A); wt_load32(A, f, lane);
    for (;;) {
        const int nx = it + stride; const bool has = nx < total;
        if (has) { wt_decode<EARLY>(nx, ap, B); wt_load32(B, g, lane); }
        wt_finish(A, f, scr, lane);
        if (!has) break;
        A = B; it = nx;
#pragma unroll
        for (int i = 0; i < 32; ++i) f[i] = g[i];
    }
}


template <bool OUTF>
__device__ __forceinline__ void rms_row(const float* xrow, const float* g, void* orow, int lane) {
    const f32x4* xr = (const f32x4*)xrow + lane;
    f32x4 v[4]; float s = 0.f;
#pragma unroll
    for (int j = 0; j < 4; ++j) { v[j] = __builtin_nontemporal_load(xr + 64 * j); s += (v[j].x * v[j].x + v[j].y * v[j].y) + (v[j].z * v[j].z + v[j].w * v[j].w); }
    const float rinv = 1.0f / sqrtf(wave_sum(s) * (1.f / 1024.f) + EPS);
#pragma unroll
    for (int j = 0; j < 4; ++j) { const f32x4 gg = ((const f32x4*)g)[lane + 64 * j]; const f32x4 o = v[j] * rinv * gg;
        if (OUTF) ((f32x4*)orow)[lane + 64 * j] = o;
        else { u32x2 w; w.x = cvt_pk_bf16(o.x, o.y); w.y = cvt_pk_bf16(o.z, o.w); ((u32x2*)orow)[lane + 64 * j] = w; } }
}

template <bool XW, bool OUTF>
__device__ __forceinline__ void resid_norm_row(const float* xin, const bf16_t* delta, float* xout, const float* g, void* hout, int lane) {
    const f32x4* xr = (const f32x4*)xin + lane; const u32x2* dr = (const u32x2*)delta + lane;
    f32x4 v[4]; float s = 0.f;
#pragma unroll
    for (int j = 0; j < 4; ++j) { const f32x4 a = xr[64 * j]; const u32x2 d = dr[64 * j];
        v[j] = (f32x4){a.x + bf_lo(d.x), a.y + bf_hi(d.x), a.z + bf_lo(d.y), a.w + bf_hi(d.y)};
        s += (v[j].x * v[j].x + v[j].y * v[j].y) + (v[j].z * v[j].z + v[j].w * v[j].w); }
    const float rinv = 1.0f / sqrtf(wave_sum(s) * (1.f / 1024.f) + EPS);
#pragma unroll
    for (int j = 0; j < 4; ++j) { if (XW) ((f32x4*)xout)[lane + 64 * j] = v[j];
        const f32x4 gg = ((const f32x4*)g)[lane + 64 * j]; const f32x4 o = v[j] * rinv * gg;
        if (OUTF) ((f32x4*)hout)[lane + 64 * j] = o;
        else { u32x2 w; w.x = cvt_pk_bf16(o.x, o.y); w.y = cvt_pk_bf16(o.z, o.w); ((u32x2*)hout)[lane + 64 * j] = w; } }
}

__device__ __forceinline__ void rms_rows4_bf16(const float* x, const float* g, bf16_t* h, size_t m0, size_t mstep, int lane) {
    constexpr int R = 4; f32x4 v[R][4]; float s[R];
#pragma unroll
    for (int r = 0; r < R; ++r) { const f32x4* xr = (const f32x4*)(x + (m0 + r * mstep) * 1024) + lane; s[r] = 0.f;
#pragma unroll
        for (int j = 0; j < 4; ++j) v[r][j] = __builtin_nontemporal_load(xr + 64 * j); }
#pragma unroll
    for (int r = 0; r < R; ++r)
#pragma unroll
        for (int j = 0; j < 4; ++j) s[r] += (v[r][j].x * v[r][j].x + v[r][j].y * v[r][j].y) + (v[r][j].z * v[r][j].z + v[r][j].w * v[r][j].w);
#pragma unroll
    for (int o = 1; o < 64; o <<= 1) {
#pragma unroll
        for (int r = 0; r < R; ++r) s[r] += __shfl_xor(s[r], o); }
#pragma unroll
    for (int r = 0; r < R; ++r) { const float rinv = 1.0f / sqrtf(s[r] * (1.f / 1024.f) + EPS); u32x2* hr = (u32x2*)(h + (m0 + r * mstep) * 1024) + lane;
#pragma unroll
        for (int j = 0; j < 4; ++j) { const f32x4 gg = ((const f32x4*)g)[lane + 64 * j]; const f32x4 o = v[r][j] * rinv * gg; u32x2 w; w.x = cvt_pk_bf16(o.x, o.y); w.y = cvt_pk_bf16(o.z, o.w); hr[64 * j] = w; } }
}

template <bool XINB, bool XW, bool OUTF>
__device__ __forceinline__ void resid_norm_row2(const void* xin, const bf16_t* delta, bf16_t* xout, const float* g, void* hout, size_t m0, size_t mstep, int lane) {
    constexpr int R = 4;
    f32x4 v[R][4]; float s[R];
    f32x4 a[R][4]; u32x2 ab[R][4], d[R][4];
#pragma unroll
    for (int r = 0; r < R; ++r) { const size_t m = m0 + r * mstep; const u32x2* dr = (const u32x2*)(delta + m * 1024) + lane; s[r] = 0.f;
#pragma unroll
        for (int j = 0; j < 4; ++j) { if (XINB) ab[r][j] = __builtin_nontemporal_load((const u32x2*)((const bf16_t*)xin + m * 1024) + lane + 64 * j); else a[r][j] = __builtin_nontemporal_load((const f32x4*)((const float*)xin + m * 1024) + lane + 64 * j); d[r][j] = __builtin_nontemporal_load(dr + 64 * j); } }
#pragma unroll
    for (int r = 0; r < R; ++r)
#pragma unroll
        for (int j = 0; j < 4; ++j) { if (XINB) a[r][j] = (f32x4){bf_lo(ab[r][j].x), bf_hi(ab[r][j].x), bf_lo(ab[r][j].y), bf_hi(ab[r][j].y)};
            v[r][j] = (f32x4){a[r][j].x + bf_lo(d[r][j].x), a[r][j].y + bf_hi(d[r][j].x), a[r][j].z + bf_lo(d[r][j].y), a[r][j].w + bf_hi(d[r][j].y)};
            s[r] += (v[r][j].x * v[r][j].x + v[r][j].y * v[r][j].y) + (v[r][j].z * v[r][j].z + v[r][j].w * v[r][j].w); }
#pragma unroll
    for (int o = 1; o < 64; o <<= 1) {
#pragma unroll
        for (int r = 0; r < R; ++r) s[r] += __shfl_xor(s[r], o); }
#pragma unroll
    for (int r = 0; r < R; ++r) { const size_t m = m0 + r * mstep; const float rinv = 1.0f / sqrtf(s[r] * (1.f / 1024.f) + EPS);
#pragma unroll
        for (int j = 0; j < 4; ++j) { if (XW) { u32x2 w; w.x = cvt_pk_bf16(v[r][j].x, v[r][j].y); w.y = cvt_pk_bf16(v[r][j].z, v[r][j].w); __builtin_nontemporal_store(w, (u32x2*)(xout + m * 1024) + lane + 64 * j); }
            const f32x4 gg = ((const f32x4*)g)[lane + 64 * j]; const f32x4 o = v[r][j] * rinv * gg;
            if (OUTF) __builtin_nontemporal_store(o, (f32x4*)((float*)hout + m * 1024) + lane + 64 * j);
            else { u32x2 w; w.x = cvt_pk_bf16(o.x, o.y); w.y = cvt_pk_bf16(o.z, o.w); ((u32x2*)((bf16_t*)hout + m * 1024))[lane + 64 * j] = w; } } }
}

__device__ __forceinline__ bf16x8 pack_step(const f32x16& x, int s) {
    u32x4 p;
    asm volatile("v_cvt_pk_bf16_f32 %0, %4, %5\n\tv_cvt_pk_bf16_f32 %1, %6, %7\n\tv_cvt_pk_bf16_f32 %2, %8, %9\n\tv_cvt_pk_bf16_f32 %3, %10, %11\n\ts_nop 1"
                 : "=&v"(p[0]), "=&v"(p[1]), "=&v"(p[2]), "=&v"(p[3])
                 : "v"(x[8 * s]), "v"(x[8 * s + 1]), "v"(x[8 * s + 2]), "v"(x[8 * s + 3]), "v"(x[8 * s + 4]), "v"(x[8 * s + 5]), "v"(x[8 * s + 6]), "v"(x[8 * s + 7]));
    return __builtin_bit_cast(bf16x8, p);
}
#define MFMA32(a, b, c) __builtin_amdgcn_mfma_f32_32x32x16_bf16((a), (b), (c), 0, 0, 0)

__device__ __forceinline__ float xhalf_max(float x) { float a = x, b = x; asm volatile("s_nop 1\n\tv_permlane32_swap_b32 %0, %1" : "+v"(a), "+v"(b)); return fmaxf(a, b); }
__device__ __forceinline__ float xhalf_sum(float x) { float a = x, b = x; asm volatile("s_nop 1\n\tv_permlane32_swap_b32 %0, %1" : "+v"(a), "+v"(b)); return a + b; }

template <int DQK, int K1W, int DV, bool BAND, bool SCALE, bool VTG, int TK, int DBG = 0>
__device__ __forceinline__ void attn_unit(LAS unsigned char* lds,
        const bf16_t* qb, size_t qs, const bf16_t* kb, size_t ks, const bf16_t* k2b, size_t k2s, const bf16_t* vb, size_t vs,
        bf16_t* ob, size_t os, float* lseb, size_t lses, int m0, int L, int kt_lo, int kt_hi, float sscale, const int wid_in) {
    constexpr int NSUB = TK / 32, NS = TK / 16;
    constexpr int KROW = DQK + 8, VROW = TK + 4, KCH = DQK / 8, NKC = TK * KCH, VCH = VTG ? TK / 8 : DV / 8, NVC = VTG ? DV * VCH : TK * VCH;
    constexpr int KPT = (NKC + NTHR - 1) / NTHR, VPT = (NVC + NTHR - 1) / NTHR, NKS = DQK / 16, NDT = DV / 32;
    constexpr int VK = (DV == 64) ? 96 : 160;
    constexpr int KBUF = TK * KROW * 2, VBUF = VTG ? DV * VROW * 2 : TK * VK * 2, BUF = KBUF + VBUF;
    static_assert(2 * BUF <= 131072, "attention tiles");
    const int lane = pg8::fresh_lane(), wid = wid_in, tid = wid * 64 + lane, r = lane & 31, hi = lane >> 5;
    const int wq0 = m0 + 32 * wid, q = wq0 + r;
    const float thr = SCALE ? 8.0f / sscale : 8.0f;
    bf16x8 qf[NKS];
#pragma unroll
    for (int k = 0; k < NKS; ++k) qf[k] = *(const bf16x8*)(qb + (size_t)q * qs + 16 * k + 8 * hi);
#pragma unroll
    for (int k = 0; k < NKS; ++k) asm volatile("" :: "v"(qf[k]));
    f32x16 o[NDT], nm;
#pragma unroll
    for (int d = 0; d < NDT; ++d)
#pragma unroll
        for (int i = 0; i < 16; ++i) o[d][i] = 0.f;
#pragma unroll
    for (int i = 0; i < 16; ++i) nm[i] = 0.f;
    float mref = 0.f, lrun = 0.f; bool started = false;
    u32x4 kreg[KPT], vreg[VPT];
#define ATT_LOAD(kt) do { \
    _Pragma("unroll") for (int i = 0; i < KPT; ++i) { const int c = tid + NTHR * i; if (NKC % NTHR == 0 || c < NKC) { const int row = c / KCH, ch = c % KCH; int key = (kt) * TK + row; if (BAND) key = key < 0 ? 0 : (key >= L ? L - 1 : key); \
        const bf16_t* src = (ch * 8 < K1W) ? kb + (size_t)key * ks + ch * 8 : k2b + (size_t)key * k2s + (ch * 8 - K1W); kreg[i] = *(const u32x4*)src; } } \
    _Pragma("unroll") for (int i = 0; i < VPT; ++i) { const int c = tid + NTHR * i; if (NVC % NTHR == 0 || c < NVC) { const int row = c / VCH, ch = c % VCH; \
        if (VTG) vreg[i] = *(const u32x4*)(vb + (size_t)row * vs + (kt) * TK + ch * 8); \
        else { int key = (kt) * TK + row; if (BAND) key = key < 0 ? 0 : (key >= L ? L - 1 : key); vreg[i] = *(const u32x4*)(vb + (size_t)key * vs + ch * 8); } } } } while (0)
#define ATT_WRITE(bi) do { LAS bf16_t* Ks_ = (LAS bf16_t*)(lds + (bi) * BUF); LAS bf16_t* Vt_ = (LAS bf16_t*)(lds + (bi) * BUF + KBUF); \
    _Pragma("unroll") for (int i = 0; i < KPT; ++i) { const int c = tid + NTHR * i; if (NKC % NTHR == 0 || c < NKC) { const int row = c / KCH, ch = c % KCH; *(LAS u32x4*)(Ks_ + row * KROW + ch * 8) = kreg[i]; } } \
    _Pragma("unroll") for (int i = 0; i < VPT; ++i) { const int c = tid + NTHR * i; if (NVC % NTHR == 0 || c < NVC) { const int row = c / VCH, ch = c % VCH; const u32x4 w = vreg[i]; \
        if (VTG) { LAS bf16_t* dst = Vt_ + row * VROW + ch * 8; *(LAS u32x2*)dst = (u32x2){w.x, w.y}; *(LAS u32x2*)(dst + 4) = (u32x2){w.z, w.w}; } \
        else { *(LAS u32x4*)(Vt_ + row * VK + ch * 8) = w; } } } } while (0)
    typedef short s16x4_t __attribute__((ext_vector_type(4)));
    auto vfrag = [&](const LAS bf16_t* Vt, int D_, int S_) -> u32x4 {
        if (VTG) { const LAS bf16_t* vp = Vt + (32 * D_ + r) * VROW + 16 * S_ + 4 * hi; const u32x2 lo = *(const LAS u32x2*)vp, hh = *(const LAS u32x2*)(vp + 8); return (u32x4){lo.x, lo.y, hh.x, hh.y}; }
        else { const int i16 = lane & 15, blk = (lane >> 4) & 1; const LAS bf16_t* vp = Vt + (16 * S_ + 4 * hi + (i16 >> 2)) * VK + 32 * D_ + 16 * blk + 4 * (i16 & 3);
            const s16x4_t lo = __builtin_amdgcn_ds_read_tr16_b64_v4i16((LAS s16x4_t*)vp), hh = __builtin_amdgcn_ds_read_tr16_b64_v4i16((LAS s16x4_t*)(vp + 8 * VK));
            const u32x2 l2 = __builtin_bit_cast(u32x2, lo), h2 = __builtin_bit_cast(u32x2, hh); return (u32x4){l2.x, l2.y, h2.x, h2.y}; } };
#define ATT_VFRAG(D_, S_) vfrag(Vt, (D_), (S_))
    ATT_LOAD(kt_lo);
    ATT_WRITE(0);
    if (kt_lo + 1 < kt_hi) ATT_LOAD(kt_lo + 1);
    if (DBG == 3) { ATT_WRITE(1); }
    __syncthreads();
    for (int kt = kt_lo; kt < kt_hi; ++kt) {
        const int cur = (kt - kt_lo) & 1;
        if (DBG != 3 && kt + 1 < kt_hi) { ATT_WRITE(cur ^ 1); if (kt + 2 < kt_hi) ATT_LOAD(kt + 2); }
        const LAS bf16_t* Ks = (const LAS bf16_t*)(lds + cur * BUF); const LAS bf16_t* Vt = (const LAS bf16_t*)(lds + cur * BUF + KBUF);
        const bool active = !BAND || !((kt * TK + TK - 1 < wq0 - 64) || (kt * TK > wq0 + 31 + 64));
        if (active) {
            f32x16 sc[NSUB];
            {
                bf16x8 ka[2][NSUB];
#pragma unroll
                for (int sub = 0; sub < NSUB; ++sub) ka[0][sub] = *(const LAS bf16x8*)(Ks + (sub * 32 + r) * KROW + 8 * hi);
#pragma unroll
                for (int k = 0; k < NKS; ++k) {
                    if (k + 1 < NKS) {
#pragma unroll
                        for (int sub = 0; sub < NSUB; ++sub) ka[(k + 1) & 1][sub] = *(const LAS bf16x8*)(Ks + (sub * 32 + r) * KROW + 16 * (k + 1) + 8 * hi);
                    }
                    __builtin_amdgcn_sched_barrier(0);
#pragma unroll
                    for (int sub = 0; sub < NSUB; ++sub) sc[sub] = MFMA32(ka[k & 1][sub], qf[k], k == 0 ? nm : sc[sub]);
                    __builtin_amdgcn_sched_barrier(0);
                }
            }
            float mxa[4] = {-INFINITY, -INFINITY, -INFINITY, -INFINITY};
#pragma unroll
            for (int sub = 0; sub < NSUB; ++sub)
#pragma unroll
                for (int i = 0; i < 16; ++i) { float v = sc[sub][i];
                    if (BAND) { const int key = kt * TK + sub * 32 + (i & 3) + 8 * (i >> 2) + 4 * hi; const int dk = key - q; const bool ok = (key >= 0) && (key < L) && (dk <= 64) && (dk >= -64); v = ok ? v : -INFINITY; sc[sub][i] = v; }
                    mxa[i & 3] = fmaxf(mxa[i & 3], v); }
            const float mx = xhalf_max(fmaxf(fmaxf(mxa[0], mxa[1]), fmaxf(mxa[2], mxa[3])));
            const bool adopt = started ? (mx > thr) : (mx > -INFINITY);
            if (__builtin_amdgcn_ballot_w64(adopt) != 0ull) {
                const float delta = adopt ? mx : 0.f;
                const float alpha = started ? __builtin_amdgcn_exp2f(SCALE ? -delta * sscale : -delta) : 1.0f;
#pragma unroll
                for (int sub = 0; sub < NSUB; ++sub)
#pragma unroll
                    for (int i = 0; i < 16; ++i) sc[sub][i] -= delta;
#pragma unroll
                for (int d = 0; d < NDT; ++d)
#pragma unroll
                    for (int i = 0; i < 16; ++i) o[d][i] *= alpha;
                lrun *= alpha; mref += delta; started = started || adopt;
#pragma unroll
                for (int i = 0; i < 16; ++i) nm[i] = -mref;
            }
            float rsa[4] = {0.f, 0.f, 0.f, 0.f};
#pragma unroll
            for (int sub = 0; sub < NSUB; ++sub)
#pragma unroll
                for (int i = 0; i < 16; ++i) { if (DBG == 1) { rsa[i & 3] = 1.f; } else { const float p = __builtin_amdgcn_exp2f(SCALE ? sc[sub][i] * sscale : sc[sub][i]); sc[sub][i] = p; rsa[i & 3] += p; } }
            lrun += (rsa[0] + rsa[1]) + (rsa[2] + rsa[3]);
            {
                u32x4 va[2][NDT];
#pragma unroll
                for (int d = 0; d < NDT; ++d) va[0][d] = ATT_VFRAG(d, 0);
#pragma unroll
                for (int s = 0; s < NS; ++s) {
                    if (s + 1 < NS) {
#pragma unroll
                        for (int d = 0; d < NDT; ++d) va[(s + 1) & 1][d] = ATT_VFRAG(d, s + 1);
                    }
                    const bf16x8 pf = pack_step(sc[s >> 1], s & 1);
                    __builtin_amdgcn_sched_barrier(0);
#pragma unroll
                    for (int d = 0; d < NDT; ++d) o[d] = MFMA32(__builtin_bit_cast(bf16x8, va[s & 1][d]), pf, o[d]);
                    __builtin_amdgcn_sched_barrier(0);
                }
            }
        }
        __syncthreads();
    }
#undef ATT_LOAD
#undef ATT_WRITE
#undef ATT_VFRAG
    const float lsum = xhalf_sum(lrun);
    const float inv = 1.0f / lsum;
#pragma unroll
    for (int d = 0; d < NDT; ++d)
#pragma unroll
        for (int g = 0; g < 4; ++g) { u32x2 w; w.x = cvt_pk_bf16(o[d][4 * g] * inv, o[d][4 * g + 1] * inv); w.y = cvt_pk_bf16(o[d][4 * g + 2] * inv, o[d][4 * g + 3] * inv);
            *(u32x2*)(ob + (size_t)q * os + 32 * d + 8 * g + 4 * hi) = w; }
    if (BAND) { if (hi == 0) lseb[(size_t)q * lses] = (SCALE ? mref * sscale : mref) + __builtin_amdgcn_logf(lsum); }
}

__device__ __forceinline__ bool xb_is_t0(int w) { return w == 0 && pg8::fresh_lane() == 0; }
#define XB_TMO      128
#define XB_XCNT(j)  (256  + 64 * (j))
#define XB_XSUB(j)  (1280 + 64 * (j))
#define XB_XGEN(j)  (2304 + 64 * (j))
#define XB_TOP      3328
#define XB_TOPGEN   3392
#define XCD_BAR_WORDS 3456
#define XB_SPIN_CAP (1u << 18)

__device__ __forceinline__ unsigned xb_ld(unsigned* p)              { return __hip_atomic_load(p, __ATOMIC_RELAXED, __HIP_MEMORY_SCOPE_AGENT); }
__device__ __forceinline__ unsigned xb_add(unsigned* p, unsigned v) { return __hip_atomic_fetch_add(p, v, __ATOMIC_RELAXED, __HIP_MEMORY_SCOPE_AGENT); }
__device__ __forceinline__ unsigned xb_xcc_id() { return (unsigned)__builtin_amdgcn_s_getreg((3 << 11) | 20) & 0xFu; }
#define XB_SPIN(cond, bar) do { unsigned _sp = 0; while (cond) { __builtin_amdgcn_s_sleep(1); \
    if ((++_sp & 255u) == 0u) { if (xb_ld(&(bar)[XB_TMO])) break; if (_sp > XB_SPIN_CAP) { atomicAdd(&(bar)[XB_TMO], 1u); break; } } } } while (0)

struct XcdBarrier {
    unsigned* bar; unsigned x;
    volatile LAS unsigned* st;
};

__device__ __forceinline__ XcdBarrier xcd_barrier_post(unsigned* bar, volatile LAS unsigned* st, const int b_wave) {
    XcdBarrier b; b.bar = bar; b.x = xb_xcc_id(); b.st = st;
    if (xb_is_t0(b_wave)) (void)xb_add(&bar[XB_XCNT(b.x)], 1u);
    return b;
}
__device__ __forceinline__ void xcd_barrier_complete(unsigned* bar, unsigned x, unsigned& nloc, unsigned& nx) {
    const unsigned G = gridDim.x * gridDim.y * gridDim.z;
    unsigned sum, cnt, mine, sp = 0u;
    for (;;) {
        sum = 0u; cnt = 0u; mine = 0u;
#pragma unroll
        for (unsigned j = 0; j < 16; ++j) { const unsigned c = xb_ld(&bar[XB_XCNT(j)]); sum += c; cnt += (c > 0u) ? 1u : 0u; mine = (j == x) ? c : mine; }
        if (sum == G) break;
        __builtin_amdgcn_s_sleep(1);
        if ((++sp & 255u) == 0u) { if (xb_ld(&bar[XB_TMO])) break; if (sp > XB_SPIN_CAP) { atomicAdd(&bar[XB_TMO], 1u); break; } }
    }
    nloc = mine > 0u ? mine : 1u; nx = cnt > 0u ? cnt : 1u;
}

__device__ __forceinline__ void xcd_barrier(const XcdBarrier& b, const int b_wave) {
    asm volatile("s_waitcnt vmcnt(0)" ::: "memory");
    __syncthreads();
    if (xb_is_t0(b_wave)) {
        unsigned* bar = b.bar;
        __builtin_amdgcn_s_waitcnt(0);
        unsigned nloc = b.st[0], nx = b.st[1];
        if (nloc == 0u) { xcd_barrier_complete(bar, b.x, nloc, nx); b.st[0] = nloc; b.st[1] = nx; }
        const unsigned old = xb_add(&bar[XB_XSUB(b.x)], 1u);
        const unsigned gen = old / nloc;
        if (old + 1u == (gen + 1u) * nloc) {
            __builtin_amdgcn_fence(__ATOMIC_RELEASE, "agent");
            asm volatile("s_waitcnt vmcnt(0)" ::: "memory");
            const unsigned og = xb_add(&bar[XB_TOP], 1u);
            const unsigned tg = og / nx;
            if (og + 1u == (tg + 1u) * nx) xb_add(&bar[XB_TOPGEN], 1u);
            else XB_SPIN(xb_ld(&bar[XB_TOPGEN]) == tg, bar);
            __builtin_amdgcn_fence(__ATOMIC_ACQUIRE, "agent");
            xb_add(&bar[XB_XGEN(b.x)], 1u);
            asm volatile("s_waitcnt vmcnt(0)" ::: "memory");
        } else {
            XB_SPIN(xb_ld(&bar[XB_XGEN(b.x)]) == gen, bar);
            __builtin_amdgcn_fence(__ATOMIC_ACQUIRE, "agent");
            asm volatile("s_waitcnt vmcnt(0)" ::: "memory");
        }
    }
    __syncthreads();
}

__global__ void __launch_bounds__(NTHR, 2) mk_fwd(Args args) {
    extern __shared__ __attribute__((aligned(16))) unsigned char lds_raw[];
    LAS unsigned char* lds = (LAS unsigned char*)lds_raw;
    cg::grid_group grid = cg::this_grid();
    const int wave = __builtin_amdgcn_readfirstlane((int)threadIdx.x >> 6);
    const int cu = blockIdx.x;
    typedef __attribute__((address_space(4))) const Args CArgs;
    const int lo = ((CArgs*)__builtin_amdgcn_kernarg_segment_ptr())->ph_lo, hi = ((CArgs*)__builtin_amdgcn_kernarg_segment_ptr())->ph_hi;
    (void)args;
#define IN(k) (lo <= (k) && (k) < hi)
    volatile LAS unsigned* xst = (volatile LAS unsigned*)(lds + 131072);
    if (xb_is_t0(wave)) { xst[0] = 0u; xst[1] = 0u; }
    __syncthreads();
    (void)xcd_barrier_post((unsigned*)(((CArgs*)__builtin_amdgcn_kernarg_segment_ptr())->ws + WS_CTL), xst, wave);
    if (hi > 1000) grid.sync();
#define SEAM(k) do { if (IN(k) && IN((k) + 1)) { XcdBarrier xb_; xb_.bar = (unsigned*)(((CArgs*)__builtin_amdgcn_kernarg_segment_ptr())->ws + WS_CTL); xb_.x = xb_xcc_id(); xb_.st = xst; xcd_barrier(xb_, wave); \
    if (PROBE_DUP == 30) xcd_barrier(xb_, wave); } } while (0)
#define PH_VARS CArgs* ap = (CArgs*)__builtin_amdgcn_kernarg_segment_ptr(); asm volatile("" : "+s"(ap)); \
    const int G = gridDim.x, NGW = G * NWAVES; const long NGT = (long)G * NTHR; \
    const int lane = pg8::fresh_lane(), tid = wave * 64 + lane; const int gw = cu * NWAVES + wave; const long gt = (long)cu * NTHR + tid; \
    unsigned char* ws = ap->ws; const float* x = ap->in[I_X]; float* out = ap->out; \
    bf16_t* H = (bf16_t*)(ws + WS_H); bf16_t* U = (bf16_t*)(ws + WS_R1); bf16_t* Z = (bf16_t*)(ws + WS_R1); bf16_t* Y = (bf16_t*)(ws + WS_R1); \
    bf16_t* QM = (bf16_t*)(ws + WS_QM); bf16_t* MEMN = (bf16_t*)(ws + WS_QM); bf16_t* KV = (bf16_t*)(ws + WS_KV); bf16_t* MEMKV = (bf16_t*)(ws + WS_MEMKV); \
    bf16_t* X1B = (bf16_t*)out; bf16_t* OMLA = (bf16_t*)((unsigned char*)out + 64 * MiB); bf16_t* DL2 = (bf16_t*)(ws + WS_QM); bf16_t* X2B = (bf16_t*)(ws + WS_QM + 64 * MiB); bf16_t* ODIL = (bf16_t*)(ws + WS_ODIL); bf16_t* OMEM = (bf16_t*)(ws + WS_OMEM); \
    float* TABM = (float*)(ws + WS_TABM); float* TABD = (float*)(ws + WS_TABD); float* LSE = (float*)(ws + WS_LSE); \
    (void)NGW; (void)NGT; (void)lane; (void)tid; (void)gw; (void)gt; (void)x; (void)out; (void)H; (void)U; (void)Z; (void)Y; (void)QM; (void)MEMN; (void)KV; (void)MEMKV; (void)X1B; (void)OMLA; (void)DL2; (void)X2B; (void)ODIL; (void)OMEM; (void)TABM; (void)TABD; (void)LSE

    if (IN(0)) for (int rep_ = 0; rep_ < (PROBE_DUP == 4 ? 2 : 1); ++rep_) {
        PH_VARS;
        LAS float* scr = (LAS float*)(lds + wave * 16384);
        wt_run<true>(ap, scr, lane, gw, NGW, WT_EARLY);
        {
            const int* pos = (const int*)ap->in[I_POS];
            for (long i = gt; i < (long)T * 24; i += NGT) { const int t = (int)(i / 24), f = (int)(i % 24);
                const float inv = f < 16 ? INV_FREQ[f] : INV_FREQ[2 * (f - 16)];
                const float ang = (float)pos[t] * inv; float c, s; sincos_acc(ang, c, s);
                float* dst = f < 16 ? TABM + (size_t)t * 32 + 2 * f : TABD + (size_t)t * 16 + 2 * (f - 16); dst[0] = c; dst[1] = s; }
        }
        for (int m = gw; m < T; m += 4 * NGW) rms_rows4_bf16(x, ap->in[I_F1N], H, (size_t)m, (size_t)NGW, lane);
        for (int m = gw; m < NB * NMEM; m += NGW) rms_row<false>(ap->in[I_MEM] + (size_t)m * D, ap->in[I_MEMN], MEMN + (size_t)m * D, lane);
        __syncthreads();
    }
    SEAM(0);
    if (IN(1)) for (int rep_ = 0; rep_ < (PROBE_DUP == 5 ? 2 : 1); ++rep_) {
        PH_VARS;
        { pg8::Gemm g{H, (const bf16_t*)(ws + WS_WGU1), T, 2 * FF, D, D, D}; pg8::StaticOrder so; so.init(T, 2 * FF, G, cu);
          pg8::EpiSwiglu E{U, FF}; pg8::gemm_phase<pg8::EpiSwiglu, pg8::StaticOrder, true, true>(lds, g, so, E, wave); }
        { pg8::Gemm g{MEMN, (const bf16_t*)(ws + WS_WMEMKV), NB * NMEM, 1024, D, D, D}; pg8::StaticOrder so; so.init(NB * NMEM, 1024, G, cu);
          pg8::EpiBf16 E{MEMKV, 1024, 1024, 1.0f, false}; pg8::gemm_phase<pg8::EpiBf16, pg8::StaticOrder, true, true>(lds, g, so, E, wave); }
        if (cu >= (NB * NMEM / 256) * 4) {
            const int nb0 = (NB * NMEM / 256) * 4, gw2 = (cu - nb0) * NWAVES + wave, NGW2 = (G - nb0) * NWAVES; const long gt2 = (long)(cu - nb0) * NTHR + tid, NGT2 = (long)(G - nb0) * NTHR;
            LAS float* scr = (LAS float*)(lds + wave * 16384);
            wt_run<false>(ap, scr, lane, gw2, NGW2, WT_TOTAL - WT_EARLY);
            {
                u32x4* p = (u32x4*)(ws + WS_WIN + (size_t)LDZ * D * 2); const long n = (long)(NZP - LDZ) * D * 2 / 16;
                for (long i = gt2; i < n; i += NGT2) p[i] = (u32x4){0u, 0u, 0u, 0u};
            }
            __syncthreads();
        }
    }
    SEAM(1);
    if (IN(2)) for (int rep_ = 0; rep_ < (PROBE_DUP == 12 ? 2 : 1); ++rep_) {
        PH_VARS;
        pg8::Gemm g{U, (const bf16_t*)(ws + WS_WD1), T, D, FF, FF, FF}; pg8::StaticOrder so; so.init(T, D, G, cu);
        pg8::EpiBf16 E{KV, D, D, 0.5f, false}; pg8::gemm_phase<pg8::EpiBf16, pg8::StaticOrder, true, true>(lds, g, so, E, wave);
    }
    SEAM(2);
    if (IN(3)) for (int rep_ = 0; rep_ < (PROBE_DUP == 13 ? 2 : 1); ++rep_) { PH_VARS; for (int m = gw; m < T; m += 4 * NGW) resid_norm_row2<false, true, false>(x, KV, X1B, ap->in[I_MIXN], H, (size_t)m, (size_t)NGW, lane); }
    SEAM(3);
    if (IN(4)) for (int rep_ = 0; rep_ < (PROBE_DUP == 14 ? 2 : 1); ++rep_) {
        PH_VARS;
        pg8::Gemm g{H, (const bf16_t*)(ws + WS_WIN), T, NZP, D, D, D}; pg8::StaticOrder so; so.init(T, NZP, G, cu);
        pg8::EpiBf16 E{Z, LDZ, LDZ, 1.0f, false}; pg8::gemm_phase<pg8::EpiBf16, pg8::StaticOrder, true, true>(lds, g, so, E, wave);
    }
    SEAM(4);
    if (IN(5)) {
        PH_VARS;
        const float* qn = ap->in[I_QN]; const float* kvn = ap->in[I_KVN];
        const float* gp = lane < 48 ? qn + lane * 8 : kvn + (lane - 48) * 8;
        const f32x4 g0 = *(const f32x4*)gp, g1 = *(const f32x4*)(gp + 4);
        const bool dl = lane < 24, kl = (lane >= 32 && lane < 36);
        const int hoff = (lane < 12 ? ZDQ : ZDK) + (lane < 12 ? lane : lane - 12) * 64, j4 = (lane & 3) * 4;
        for (int t0 = gw; t0 < T; t0 += 4 * NGW) {
            u32x4 w[4], ra[4], rb[4]; u32x2 ka[4], kb[4]; f32x4 tb[4][4];
#pragma unroll
            for (int u = 0; u < 4; ++u) { const int t = t0 + u * NGW; if (t < T) { const bf16_t* zr = Z + (size_t)t * LDZ;
                w[u] = *(const u32x4*)(zr + lane * 8);
                if (dl) { ra[u] = *(const u32x4*)(zr + hoff); rb[u] = *(const u32x4*)(zr + hoff + 8);
#pragma unroll
                    for (int i = 0; i < 4; ++i) tb[u][i] = *(const f32x4*)(TABD + (size_t)t * 16 + 4 * i); }
                else if (kl) { ka[u] = *(const u32x2*)(zr + ZKR + j4); kb[u] = *(const u32x2*)(zr + ZKR + 16 + j4); tb[u][0] = *(const f32x4*)(TABM + (size_t)t * 32 + 2 * j4); tb[u][1] = *(const f32x4*)(TABM + (size_t)t * 32 + 2 * j4 + 4); } } }
#pragma unroll
            for (int u = 0; u < 4; ++u) { const int t = t0 + u * NGW; if (t < T) { bf16_t* zr = Z + (size_t)t * LDZ;
                const float f[8] = {bf_lo(w[u].x), bf_hi(w[u].x), bf_lo(w[u].y), bf_hi(w[u].y), bf_lo(w[u].z), bf_hi(w[u].z), bf_lo(w[u].w), bf_hi(w[u].w)};
                float ss = 0.f;
#pragma unroll
                for (int j = 0; j < 8; ++j) ss += f[j] * f[j];
#pragma unroll
                for (int o = 1; o < 16; o <<= 1) ss += __shfl_xor(ss, o);
                float tot = ss; tot += __shfl_xor(tot, 16); tot += __shfl_xor(tot, 32);
                const float skv = __builtin_bit_cast(float, __builtin_amdgcn_readlane(__builtin_bit_cast(int, ss), 63)), sq = tot - skv;
                const float rinv = lane < 48 ? 1.0f / sqrtf(sq * (1.f / 384.f) + EPS) : 1.0f / sqrtf(skv * (1.f / 128.f) + EPS);
                u32x4 o; o.x = cvt_pk_bf16(f[0] * rinv * g0.x, f[1] * rinv * g0.y); o.y = cvt_pk_bf16(f[2] * rinv * g0.z, f[3] * rinv * g0.w);
                o.z = cvt_pk_bf16(f[4] * rinv * g1.x, f[5] * rinv * g1.y); o.w = cvt_pk_bf16(f[6] * rinv * g1.z, f[7] * rinv * g1.w);
                *(u32x4*)(zr + lane * 8) = o;
                if (dl) {
                    const u32x4 a = ra[u], b = rb[u]; const f32x4 t0_ = tb[u][0], t1 = tb[u][1], t2 = tb[u][2], t3 = tb[u][3];
                    const float x1[8] = {bf_lo(a.x), bf_hi(a.x), bf_lo(a.y), bf_hi(a.y), bf_lo(a.z), bf_hi(a.z), bf_lo(a.w), bf_hi(a.w)};
                    const float x2[8] = {bf_lo(b.x), bf_hi(b.x), bf_lo(b.y), bf_hi(b.y), bf_lo(b.z), bf_hi(b.z), bf_lo(b.w), bf_hi(b.w)};
                    const float cs[8] = {t0_.x, t0_.z, t1.x, t1.z, t2.x, t2.z, t3.x, t3.z}, sn[8] = {t0_.y, t0_.w, t1.y, t1.w, t2.y, t2.w, t3.y, t3.w};
                    float y1[8], y2[8];
#pragma unroll
                    for (int i = 0; i < 8; ++i) { y1[i] = x1[i] * cs[i] - x2[i] * sn[i]; y2[i] = x2[i] * cs[i] + x1[i] * sn[i]; }
                    u32x4 oa, ob; oa.x = cvt_pk_bf16(y1[0], y1[1]); oa.y = cvt_pk_bf16(y1[2], y1[3]); oa.z = cvt_pk_bf16(y1[4], y1[5]); oa.w = cvt_pk_bf16(y1[6], y1[7]);
                    ob.x = cvt_pk_bf16(y2[0], y2[1]); ob.y = cvt_pk_bf16(y2[2], y2[3]); ob.z = cvt_pk_bf16(y2[4], y2[5]); ob.w = cvt_pk_bf16(y2[6], y2[7]);
                    *(u32x4*)(zr + hoff) = oa; *(u32x4*)(zr + hoff + 8) = ob;
                } else if (kl) {
                    const u32x2 a = ka[u], b = kb[u]; const f32x4 t0_ = tb[u][0], t1 = tb[u][1];
                    const float x1[4] = {bf_lo(a.x), bf_hi(a.x), bf_lo(a.y), bf_hi(a.y)}, x2[4] = {bf_lo(b.x), bf_hi(b.x), bf_lo(b.y), bf_hi(b.y)};
                    const float cs[4] = {t0_.x, t0_.z, t1.x, t1.z}, sn[4] = {t0_.y, t0_.w, t1.y, t1.w};
                    float y1[4], y2[4];
#pragma unroll
                    for (int i = 0; i < 4; ++i) { y1[i] = x1[i] * cs[i] - x2[i] * sn[i]; y2[i] = x2[i] * cs[i] + x1[i] * sn[i]; }
                    u32x2 oa, ob; oa.x = cvt_pk_bf16(y1[0], y1[1]); oa.y = cvt_pk_bf16(y1[2], y1[3]); ob.x = cvt_pk_bf16(y2[0], y2[1]); ob.y = cvt_pk_bf16(y2[2], y2[3]);
                    *(u32x2*)(zr + ZKR + j4) = oa; *(u32x2*)(zr + ZKR + 16 + j4) = ob;
                } } }
        }
    }
    SEAM(5);
    if (IN(6)) {
        PH_VARS;
        for (int rep6_ = 0; rep6_ < (PROBE_DUP == 40 ? 2 : 1); ++rep6_) {
        { pg8::Gemm g{Z + ZQ, (const bf16_t*)(ws + WS_WUQ), T, 768, 384, LDZ, 384}; pg8::StaticOrder so; so.init(T, 768, G, cu);
          pg8::EpiQRope E{QM, 768, TABM, 0.10206207261596575f * LOG2E}; pg8::gemm_phase<pg8::EpiQRope, pg8::StaticOrder, true, true>(lds, g, so, E, wave); }
        { pg8::Gemm g{Z + ZKV, (const bf16_t*)(ws + WS_WUKV), T, 512, 128, LDZ, 128}; pg8::StaticOrder so; so.init(T, 512, G, cu);
          pg8::EpiBf16 E{KV, 512, 512, 1.0f, false}; pg8::gemm_phase<pg8::EpiBf16, pg8::StaticOrder, true, true>(lds, g, so, E, wave); }
        { pg8::Gemm g{(const bf16_t*)(ws + WS_WUKV) + 512 * 128, Z + ZKV, 512, T, 128, 128, LDZ}; pg8::StaticOrder so; so.init(512, T, G, cu);
          pg8::EpiBf16 E{KV + (size_t)T * 512, T, T, 1.0f, false}; pg8::gemm_phase<pg8::EpiBf16, pg8::StaticOrder, true, true>(lds, g, so, E, wave); }
        }
        for (int u = cu; u < NB * 12 * 16; u += G) {
            const int b = u / 192, rem = u % 192, gh = rem / 16, i16 = rem % 16, g = gh >> 2, h = gh & 3;
            const int dil = (g == 0) ? 1 : (g == 1 ? 4 : 16), L = S / dil, bpc = 16 / dil, rr = i16 / bpc, mb = i16 % bpc, m0 = mb * 256;
            bf16_t* base = Z + (size_t)(b * S + rr) * LDZ + gh * 64; const size_t st = (size_t)dil * LDZ;
            int kt_lo = m0 / 64 - 1, kt_hi = m0 / 64 + 5; if (kt_lo < 0) kt_lo = 0; if (kt_hi > L / 64) kt_hi = L / 64;
            float* lb = LSE + (size_t)g * T * 4 + (size_t)(b * S + rr) * 4 + h;
            attn_unit<64, 64, 64, true, true, false, 64>(lds, base + ZDQ, st, base + ZDK, st, base + ZDK, st, base + ZDV, st, base + ZDQ, st, lb, (size_t)dil * 4, m0, L, kt_lo, kt_hi, 0.125f * LOG2E, wave);
        }
#if PROBE_DUP == 2
        for (int u = cu; u < NB * 12 * 16; u += G) {
            const int b = u / 192, rem = u % 192, gh = rem / 16, i16 = rem % 16, g = gh >> 2, h = gh & 3;
            const int dil = (g == 0) ? 1 : (g == 1 ? 4 : 16), L = S / dil, bpc = 16 / dil, rr = i16 / bpc, mb = i16 % bpc, m0 = mb * 256;
            bf16_t* base = Z + (size_t)(b * S + rr) * LDZ + gh * 64; const size_t st = (size_t)dil * LDZ;
            int kt_lo = m0 / 64 - 1, kt_hi = m0 / 64 + 5; if (kt_lo < 0) kt_lo = 0; if (kt_hi > L / 64) kt_hi = L / 64;
            attn_unit<64, 64, 64, true, true, false, 64>(lds, base + ZDQ, st, base + ZDK, st, base + ZDK, st, base + ZDV, st, ODIL + (size_t)cu * 16384 - (size_t)m0 * 64, 64, (float*)(ODIL + (size_t)4194304) + cu * 256 - m0, 1, m0, L, kt_lo, kt_hi, 0.125f * LOG2E, wave);
            (void)h;
        }
#endif
        for (int u = cu; u < NB * 4 * 16; u += G) {
            const int b = u / 64, h = (u / 16) % 4, qb = u % 16;
            const bf16_t* kbase = MEMKV + (size_t)b * NMEM * 1024 + h * 128;
            attn_unit<128, 128, 128, false, true, false, 64>(lds, Z + (size_t)b * S * LDZ + ZMQ + h * 128, LDZ, kbase, 1024, kbase, 1024, kbase + 512, 1024,
                                                  OMEM + (size_t)b * S * 512 + h * 128, 512, nullptr, 0, qb * 256, NMEM, 0, NMEM / 64, 0.08838834764831845f * LOG2E, wave);
        }
#if PROBE_DUP == 3
        for (int u = cu; u < NB * 4 * 16; u += G) {
            const int b = u / 64, h = (u / 16) % 4, qb = u % 16;
            const bf16_t* kbase = MEMKV + (size_t)b * NMEM * 1024 + h * 128;
            attn_unit<128, 128, 128, false, true, false, 64>(lds, Z + (size_t)b * S * LDZ + ZMQ + h * 128, LDZ, kbase, 1024, kbase, 1024, kbase + 512, 1024,
                                                  OMEM + (size_t)b * S * 512 + h * 128, 512, nullptr, 0, qb * 256, NMEM, 0, NMEM / 64, 0.08838834764831845f * LOG2E, wave);
        }
#endif
        __syncthreads();
    }
    SEAM(6);
    if (IN(7)) {
        PH_VARS;
        {
            const int h = lane >> 4, d0 = (lane & 15) * 4;
            for (int t0 = gw; t0 < T; t0 += 4 * NGW) {
                float l[4][3]; u32x2 wv[4][3];
#pragma unroll
                for (int u = 0; u < 4; ++u) { const int t = t0 + u * NGW; if (t < T) {
#pragma unroll
                    for (int g = 0; g < 3; ++g) { l[u][g] = LSE[(size_t)g * T * 4 + (size_t)t * 4 + h]; wv[u][g] = *(const u32x2*)(Z + (size_t)t * LDZ + ZDQ + (g * 4 + h) * 64 + d0); } } }
#pragma unroll
                for (int u = 0; u < 4; ++u) { const int t = t0 + u * NGW; if (t < T) {
                    const float mx = fmaxf(l[u][0], fmaxf(l[u][1], l[u][2]));
                    const float e0 = __builtin_amdgcn_exp2f(l[u][0] - mx), e1 = __builtin_amdgcn_exp2f(l[u][1] - mx), e2 = __builtin_amdgcn_exp2f(l[u][2] - mx), inv = 1.0f / (e0 + e1 + e2);
                    const float r0 = (e0 * bf_lo(wv[u][0].x) + e1 * bf_lo(wv[u][1].x) + e2 * bf_lo(wv[u][2].x)) * inv, r1 = (e0 * bf_hi(wv[u][0].x) + e1 * bf_hi(wv[u][1].x) + e2 * bf_hi(wv[u][2].x)) * inv;
                    const float r2 = (e0 * bf_lo(wv[u][0].y) + e1 * bf_lo(wv[u][1].y) + e2 * bf_lo(wv[u][2].y)) * inv, r3 = (e0 * bf_hi(wv[u][0].y) + e1 * bf_hi(wv[u][1].y) + e2 * bf_hi(wv[u][2].y)) * inv;
                    u32x2 w; w.x = cvt_pk_bf16(r0, r1); w.y = cvt_pk_bf16(r2, r3);
                    *(u32x2*)(ODIL + (size_t)t * 256 + h * 64 + d0) = w; } }
            }
        }
        for (int u = cu; u < NB * 8 * 16; u += G) {
            const int b = u / 128, h = (u / 16) % 8, qb = u % 16;
            bf16_t* qbase = QM + (size_t)b * S * 768 + h * 96;
            const bf16_t* kbase = KV + (size_t)b * S * 512 + h * 64; const bf16_t* vtb = KV + (size_t)T * 512 + (size_t)(h * 64) * T + (size_t)b * S;
            attn_unit<96, 64, 64, false, false, true, 128>(lds, qbase, 768, kbase, 512, Z + (size_t)b * S * LDZ + ZKR, LDZ, vtb, T, OMLA + (size_t)b * S * 512 + h * 64, 512, nullptr, 0, qb * 256, S, 0, S / 128, 1.0f, wave);
        }
#if PROBE_DUP == 1
        for (int u = cu; u < NB * 8 * 16; u += G) {
            const int b = u / 128, h = (u / 16) % 8, qb = u % 16;
            bf16_t* qbase = QM + (size_t)b * S * 768 + h * 96;
            const bf16_t* kbase = KV + (size_t)b * S * 512 + h * 64; const bf16_t* vtb = KV + (size_t)T * 512 + (size_t)(h * 64) * T + (size_t)b * S;
            attn_unit<96, 64, 64, false, false, true, 128, PROBE_DBG>(lds, qbase, 768, kbase, 512, Z + (size_t)b * S * LDZ + ZKR, LDZ, vtb, T, MEMKV + (size_t)(cu & 127) * 16384 - (size_t)qb * 256 * 64, 64, nullptr, 0, qb * 256, S, 0, S / 128, 1.0f, wave);
        }
#endif
        __syncthreads();
    }
    SEAM(7);
    if (IN(8)) for (int rep_ = 0; rep_ < (PROBE_DUP == 18 ? 2 : 1); ++rep_) {
        PH_VARS;
        { pg8::Gemm g{OMLA, (const bf16_t*)(ws + WS_WOMLA), T, D, 512, 512, 512}; pg8::StaticOrder so; so.init(T, D, G, cu);
          pg8::EpiBf16 E{Y, D, D, 1.0f, true}; pg8::gemm_phase<pg8::EpiBf16, pg8::StaticOrder, true, true>(lds, g, so, E, wave); }
        { pg8::Gemm g{ODIL, (const bf16_t*)(ws + WS_WODIL), T, D, 256, 256, 256}; pg8::StaticOrder so; so.init(T, D, G, cu);
          pg8::EpiBf16 E{Y + (size_t)T * D, D, D, 1.0f, true}; pg8::gemm_phase<pg8::EpiBf16, pg8::StaticOrder, true, true>(lds, g, so, E, wave); }
        { pg8::Gemm g{OMEM, (const bf16_t*)(ws + WS_WOMEM), T, D, 512, 512, 512}; pg8::StaticOrder so; so.init(T, D, G, cu);
          pg8::EpiBf16 E{Y + (size_t)2 * T * D, D, D, 1.0f, true}; pg8::gemm_phase<pg8::EpiBf16, pg8::StaticOrder, true, true>(lds, g, so, E, wave); }
    }
    if (IN(9)) {
        PH_VARS;
        pg8::Gemm g{H, (const bf16_t*)(ws + WS_WGATE), T, 3072, D, D, D}; pg8::GateOrder so; so.init(T, G, cu);
        pg8::EpiGateMul E{Y, (size_t)T * D}; pg8::gemm_phase<pg8::EpiGateMul, pg8::GateOrder, true, true>(lds, g, so, E, wave);
    }
    SEAM(9);
    if (IN(10)) for (int rep_ = 0; rep_ < (PROBE_DUP == 20 ? 2 : 1); ++rep_) {
        PH_VARS;
        pg8::Gemm g{Y + (size_t)2 * T * D  , (const bf16_t*)(ws + WS_WOUT), T, D, D, D, D}; pg8::StaticOrder so; so.init(T, D, G, cu);
        pg8::EpiBf16 E{DL2, D, D, 1.0f, false}; pg8::gemm_phase<pg8::EpiBf16, pg8::StaticOrder, true, true>(lds, g, so, E, wave);
    }
    SEAM(10);
    if (IN(11)) for (int rep_ = 0; rep_ < (PROBE_DUP == 21 ? 2 : 1); ++rep_) { PH_VARS; for (int m = gw; m < T; m += 4 * NGW) resid_norm_row2<true, true, false>(X1B, DL2, X2B, ap->in[I_F2N], H, (size_t)m, (size_t)NGW, lane); }
    SEAM(11);
    if (IN(12)) for (int rep_ = 0; rep_ < (PROBE_DUP == 22 ? 2 : 1); ++rep_) {
        PH_VARS;
        pg8::Gemm g{H, (const bf16_t*)(ws + WS_WGU2), T, 2 * FF, D, D, D}; pg8::StaticOrder so; so.init(T, 2 * FF, G, cu);
        pg8::EpiSwiglu E{U, FF}; pg8::gemm_phase<pg8::EpiSwiglu, pg8::StaticOrder, true, true>(lds, g, so, E, wave);
    }
    SEAM(12);
    if (IN(13)) for (int rep_ = 0; rep_ < (PROBE_DUP == 23 ? 2 : 1); ++rep_) {
        PH_VARS;
        pg8::Gemm g{U, (const bf16_t*)(ws + WS_WD2), T, D, FF, FF, FF}; pg8::StaticOrder so; so.init(T, D, G, cu);
        pg8::EpiBf16 E{DL2, D, D, 0.5f, false}; pg8::gemm_phase<pg8::EpiBf16, pg8::StaticOrder, true, true>(lds, g, so, E, wave);
    }
    SEAM(13);
    if (IN(14)) { PH_VARS; for (int m = gw; m < T; m += 4 * NGW) resid_norm_row2<true, false, true>(X2B, DL2, nullptr, ap->in[I_FINN], out, (size_t)m, (size_t)NGW, lane); }
#undef IN
#undef SEAM
}
constexpr int N_PHASES = 15;

extern "C" void kernel_launch(void* const* d_in, const int* in_sizes, int n_in, void* d_out, int out_size, void* d_ws, size_t ws_size, hipStream_t stream) {
    static int grid = 0;
    if (grid == 0) {
        if (n_in != 24 || out_size != T * D || ws_size < WS_END) { fprintf(stderr, "kernel_launch: unexpected problem (n_in %d, out %d, ws %zu < %zu)\n", n_in, out_size, ws_size, (size_t)WS_END); grid = -1; return; }
        int dev = 0, cus = 0, per_cu = 0;
        if (hipGetDevice(&dev) != hipSuccess || hipDeviceGetAttribute(&cus, hipDeviceAttributeMultiprocessorCount, dev) != hipSuccess) { grid = -1; return; }
        if (hipFuncSetAttribute((const void*)mk_fwd, hipFuncAttributeMaxDynamicSharedMemorySize, LDS_BYTES) != hipSuccess) { fprintf(stderr, "kernel_launch: hipFuncSetAttribute failed\n"); grid = -1; return; }
        if (hipOccupancyMaxActiveBlocksPerMultiprocessor(&per_cu, (const void*)mk_fwd, NTHR, LDS_BYTES) != hipSuccess || per_cu < 1) { fprintf(stderr, "kernel_launch: occupancy query says %d\n", per_cu); per_cu = 1; }
        (void)hipGetLastError();
        grid = cus;
    }
    if (grid < 0) return;
    if (hipMemsetAsync((char*)d_ws + WS_CTL, 0, 16384, stream) != hipSuccess) { fprintf(stderr, "kernel_launch: memset failed\n"); return; }
    Args a{};
    for (int i = 0; i < 24; ++i) a.in[i] = (const float*)d_in[i];
    a.out = (float*)d_out; a.ws = (unsigned char*)d_ws;
#if MK_PER_PHASE
    for (int p = 0; p < N_PHASES; ++p) {
        a.ph_lo = p; a.ph_hi = p + 1; void* kargs[] = {&a};
        hipError_t e = hipLaunchCooperativeKernel((const void*)mk_fwd, dim3(grid), dim3(NTHR), kargs, LDS_BYTES, stream);
        if (e != hipSuccess) { fprintf(stderr, "kernel_launch: cooperative launch (phase %d) failed: %s\n", p, hipGetErrorString(e)); break; }
    }
#else
    a.ph_lo = 0; a.ph_hi = N_PHASES; void* kargs[] = {&a};
    hipError_t e = hipLaunchCooperativeKernel((const void*)mk_fwd, dim3(grid), dim3(NTHR), kargs, LDS_BYTES, stream);
    if (e != hipSuccess) fprintf(stderr, "kernel_launch: cooperative launch failed: %s (grid %d)\n", hipGetErrorString(e), grid);
#endif
}
```
